# Optimizing an MI355X kernel written in HIP

```python
import math
import jax, jax.numpy as jnp
from jax import lax
import numpy as np

D_MODEL = 1024
BATCH = 8
SEQ = 2048
DEPTH = 2
DEC_BATCH = 128
DEC_SEQ = 4
PAST_LEN = 16384
PAGE_SIZE = 128

N_META = 16
N_A = (DEPTH + 1) // 2
N_B = DEPTH // 2
NORM_EPS = 1e-5
RW_HEAD = 64
RW_HEADS = D_MODEL // RW_HEAD
DECAY_LORA = 64
AAA_LORA = 64
GATE_LORA = 160
RW_LN_EPS = 64e-5
M_EXPAND = 2
M_D_INNER = M_EXPAND * D_MODEL
M_HEADDIM = 64
M_HEADS = M_D_INNER // M_HEADDIM
M_GROUPS = 4
M_HPG = M_HEADS // M_GROUPS
M_STATE = 128
M_CONV = 4
M_CONV_DIM = M_D_INNER + 2 * M_GROUPS * M_STATE
M_IN_DIM = 2 * M_D_INNER + 2 * M_GROUPS * M_STATE + M_HEADS
M_CHUNK = 128
P_HEADS = 8
P_NKEYS = 128
P_EXPERTS = P_NKEYS ** 2
P_QDIM = 256
P_TOPK = 16
P_BLOCK = 128

kernel_name = 'hybrid_rwkv7_mamba2_peer_step'

F32 = jnp.float32


def rms_norm(x, g):
    xf = x.astype(F32)
    y = xf * lax.rsqrt(jnp.mean(xf * xf, axis=-1, keepdims=True) + NORM_EPS)
    return (y * g.astype(F32)).astype(x.dtype)


def rwkv7_time_mix(xn, shift0, wkv0, mix, w_rkv, w0, w1, w2, a0, a1, a2, g1, g2,
                   k_k, k_a, r_k, ln_w, ln_b, w_o):
    bsz, L, D = xn.shape
    H, N = RW_HEADS, RW_HEAD
    prev = jnp.concatenate([shift0[:, None, :].astype(xn.dtype), xn[:, :-1]], axis=1)
    dx = prev - xn
    xr, xw, xk, xv, xa, xg = [xn + dx * mix[j] for j in range(6)]
    r = xr @ w_rkv[0]
    k = xk @ w_rkv[1]
    v = xv @ w_rkv[2]
    w_log = -jax.nn.softplus(-(w0 + jnp.tanh(xw @ w1) @ w2)) - 0.5
    decay = jnp.exp(-jnp.exp(w_log.astype(F32)))
    a = jax.nn.sigmoid(a0 + (xa @ a1) @ a2)
    g = jax.nn.sigmoid(xg @ g1) @ g2
    kk = (k * k_k).reshape(bsz, L, H, N).astype(F32)
    kk = kk / jnp.maximum(jnp.linalg.norm(kk, axis=-1, keepdims=True), 1e-12)
    k = k * (1 + (a - 1) * k_a)

    def heads(t):
        return t.reshape(bsz, L, H, N).astype(F32)

    r_h, k_h, v_h, a_h, w_h = heads(r), heads(k), heads(v), heads(a), heads(decay)

    def step(S, inp):
        r_t, w_t, k_t, v_t, kk_t, a_t = inp
        s_kk = jnp.einsum('bhvk,bhk->bhv', S, -kk_t)
        S = (S * w_t[:, :, None, :]
             + s_kk[..., None] * (kk_t * a_t)[:, :, None, :]
             + v_t[..., None] * k_t[:, :, None, :])
        return S, jnp.einsum('bhvk,bhk->bhv', S, r_t)

    seq = tuple(jnp.swapaxes(t, 0, 1) for t in (r_h, w_h, k_h, v_h, kk, a_h))
    S_fin, o = lax.scan(step, wkv0.astype(F32), seq)
    o = jnp.swapaxes(o, 0, 1)
    mu = jnp.mean(o, axis=-1, keepdims=True)
    var = jnp.mean(jnp.square(o - mu), axis=-1, keepdims=True)
    o = ((o - mu) * lax.rsqrt(var + RW_LN_EPS)).reshape(bsz, L, D) * ln_w + ln_b
    bonus = jnp.sum(r_h * k_h * r_k, axis=-1, keepdims=True) * v_h
    o = (o + bonus.reshape(bsz, L, D)).astype(xn.dtype)
    out = (o * g) @ w_o
    return out, xn[:, -1], S_fin.astype(xn.dtype)


def segsum(x):
    T = x.shape[-1]
    xe = jnp.broadcast_to(x[..., :, None], x.shape + (T,))
    low = jnp.tril(jnp.ones((T, T), dtype=bool), -1)
    cs = jnp.cumsum(jnp.where(low, xe, 0.0), axis=-2)
    return jnp.where(jnp.tril(jnp.ones((T, T), dtype=bool)), cs, -jnp.inf)


def ssd(x, dt, A, Bm, Cm, h0, lead_pad, chunk):
    b, L = x.shape[:2]
    padt = lambda t: jnp.pad(t, [(0, 0), (lead_pad, 0)] + [(0, 0)] * (t.ndim - 2))
    x, dt, Bm, Cm = padt(x), padt(dt), padt(Bm), padt(Cm)
    Lp = L + lead_pad
    nc = Lp // chunk
    x = x.reshape(b, nc, chunk, M_GROUPS, M_HPG, M_HEADDIM)
    dt = dt.reshape(b, nc, chunk, M_GROUPS, M_HPG)
    Bm = Bm.reshape(b, nc, chunk, M_GROUPS, M_STATE)
    Cm = Cm.reshape(b, nc, chunk, M_GROUPS, M_STATE)
    xdt = x * dt[..., None]
    adt = jnp.moveaxis(dt * A, 2, -1)
    a_cs = jnp.cumsum(adt, axis=-1)
    Lmat = jnp.exp(segsum(adt))
    cb = jnp.einsum('bclgn,bcsgn->bcgls', Cm, Bm)
    y_diag = jnp.einsum('bcgls,bcgrls,bcsgrp->bclgrp', cb, Lmat, xdt)
    decay_st = jnp.exp(a_cs[..., -1:] - a_cs)
    st = jnp.einsum('bclgn,bcgrl,bclgrp->bcgrpn', Bm, decay_st, xdt)
    chunk_decay = jnp.exp(a_cs[..., -1])

    def step(h, inp):
        s_c, d_c = inp
        return h * d_c[..., None, None] + s_c, h

    h_fin, h_in = lax.scan(step, h0, (jnp.moveaxis(st, 1, 0), jnp.moveaxis(chunk_decay, 1, 0)))
    h_in = jnp.moveaxis(h_in, 0, 1)
    y_off = jnp.einsum('bclgn,bcgrpn,bcgrl->bclgrp', Cm, h_in, jnp.exp(a_cs))
    y = (y_diag + y_off).reshape(b, Lp, M_GROUPS, M_HPG, M_HEADDIM)[:, lead_pad:]
    return y, h_fin


def mamba2_mix(xn, conv0, ssm0, in_proj, conv_w, conv_b, dt_bias, a_log, d_skip, norm_w, out_proj,
               lead_pad, chunk):
    bsz, L, _ = xn.shape
    zxbcdt = xn @ in_proj
    z = zxbcdt[..., :M_D_INNER]
    xbc = zxbcdt[..., M_D_INNER:M_D_INNER + M_CONV_DIM]
    dt_raw = zxbcdt[..., M_D_INNER + M_CONV_DIM:]
    full = jnp.concatenate([conv0.astype(xn.dtype), xbc], axis=1)
    conv = conv_b + sum(full[:, j:j + L] * conv_w[j] for j in range(M_CONV))
    new_conv = full[:, L:]
    xbc = jax.nn.silu(conv).astype(F32)
    xs = xbc[..., :M_D_INNER].reshape(bsz, L, M_GROUPS, M_HPG, M_HEADDIM)
    Bm = xbc[..., M_D_INNER:M_D_INNER + M_GROUPS * M_STATE].reshape(bsz, L, M_GROUPS, M_STATE)
    Cm = xbc[..., M_D_INNER + M_GROUPS * M_STATE:].reshape(bsz, L, M_GROUPS, M_STATE)
    dt = jax.nn.softplus((dt_raw + dt_bias).astype(F32)).reshape(bsz, L, M_GROUPS, M_HPG)
    A = -jnp.exp(a_log.astype(F32)).reshape(M_GROUPS, M_HPG)
    h0 = ssm0.astype(F32).reshape(bsz, M_GROUPS, M_HPG, M_HEADDIM, M_STATE)
    y, h_fin = ssd(xs, dt, A, Bm, Cm, h0, lead_pad, chunk)
    y = y + d_skip.astype(F32).reshape(M_GROUPS, M_HPG)[..., None] * xs
    y = y.reshape(bsz, L, M_D_INNER)
    yg = (y * jax.nn.silu(z.astype(F32))).reshape(bsz, L, M_GROUPS, M_D_INNER // M_GROUPS)
    yg = yg * lax.rsqrt(jnp.mean(yg * yg, axis=-1, keepdims=True) + NORM_EPS)
    yg = (yg.reshape(bsz, L, M_D_INNER) * norm_w).astype(xn.dtype)
    out = yg @ out_proj
    ssm_new = h_fin.reshape(bsz, M_HEADS, M_HEADDIM, M_STATE).astype(xn.dtype)
    return out, new_conv, ssm_new


def peer_ffn(xn, w_q, sub_keys, u_tab, v_tab):
    bsz, L, D = xn.shape
    T = bsz * L
    xt = xn.reshape(T, D)
    q = (xt @ w_q).reshape(T, P_HEADS, 2, P_QDIM // 2)
    s = jnp.einsum('thzd,zhkd->thzk', q, sub_keys).astype(F32)
    sv, si = lax.top_k(s, P_TOPK)
    cand = sv[:, :, 0, :, None] + sv[:, :, 1, None, :]
    cand_idx = si[:, :, 0, :, None] * P_NKEYS + si[:, :, 1, None, :]
    top_s, pos = lax.top_k(cand.reshape(T, P_HEADS, P_TOPK * P_TOPK), P_TOPK)
    eidx = jnp.take_along_axis(cand_idx.reshape(T, P_HEADS, P_TOPK * P_TOPK), pos, axis=-1)
    gate = jax.nn.softmax(top_s, axis=-1).astype(xn.dtype)
    eidx = eidx.reshape(T, P_HEADS * P_TOPK)
    gate = gate.reshape(T, P_HEADS * P_TOPK)
    pad = (-T) % P_BLOCK
    nb = (T + pad) // P_BLOCK
    xb = jnp.pad(xt, ((0, pad), (0, 0))).reshape(nb, P_BLOCK, D)
    ib = jnp.pad(eidx, ((0, pad), (0, 0))).reshape(nb, P_BLOCK, P_HEADS * P_TOPK)
    gb = jnp.pad(gate, ((0, pad), (0, 0))).reshape(nb, P_BLOCK, P_HEADS * P_TOPK)

    def block(args):
        x_blk, i_blk, g_blk = args
        u = u_tab[i_blk]
        v = v_tab[i_blk]
        act = jax.nn.gelu(jnp.einsum('td,ted->te', x_blk, u), approximate=False)
        return jnp.einsum('te,ted->td', g_blk * act, v)

    out = lax.map(block, (xb, ib, gb)).reshape(nb * P_BLOCK, D)[:T]
    return out.reshape(bsz, L, D)


def setup_inputs(seed: int = 0) -> dict:
    key = jax.random.key(seed)
    ks = iter(jax.random.split(key, 64))
    D = D_MODEL

    def nrm(shape, scale=1.0):
        return jax.random.normal(next(ks), shape, F32) * scale

    def unif(shape, lo, hi):
        return jax.random.uniform(next(ks), shape, F32, lo, hi)

    dt0 = jnp.exp(unif((N_B, M_HEADS), math.log(1e-3), math.log(1e-1)))
    return {
        'x_prompt': nrm((BATCH, SEQ, D)),
        'x_sample': nrm((DEC_BATCH, DEC_SEQ, D)),
        'state_rwkv_shift': nrm((N_A, DEC_BATCH, D)),
        'state_rwkv_wkv': nrm((N_A, DEC_BATCH, RW_HEADS, RW_HEAD, RW_HEAD), 0.3),
        'state_mamba_conv': nrm((N_B, DEC_BATCH, M_CONV - 1, M_CONV_DIM)),
        'state_mamba_ssm': nrm((N_B, DEC_BATCH, M_HEADS, M_HEADDIM, M_STATE), 0.1),
        'meta_tokens': nrm((N_META, D)),
        'norm_mix': 1.0 + nrm((DEPTH, D), 0.05),
        'norm_ffn': 1.0 + nrm((DEPTH, D), 0.05),
        'norm_final': 1.0 + nrm((D,), 0.05),
        'rwkv_mix': unif((N_A, 6, D), 0.0, 1.0),
        'rwkv_w_rkv': nrm((N_A, 3, D, D), D ** -0.5),
        'rwkv_w0': unif((N_A, D), -5.0, 1.0),
        'rwkv_w1': nrm((N_A, D, DECAY_LORA), D ** -0.5),
        'rwkv_w2': nrm((N_A, DECAY_LORA, D), 0.1 * DECAY_LORA ** -0.5),
        'rwkv_a0': nrm((N_A, D), 0.1),
        'rwkv_a1': nrm((N_A, D, AAA_LORA), D ** -0.5),
        'rwkv_a2': nrm((N_A, AAA_LORA, D), 0.1 * AAA_LORA ** -0.5),
        'rwkv_g1': nrm((N_A, D, GATE_LORA), D ** -0.5),
        'rwkv_g2': nrm((N_A, GATE_LORA, D), GATE_LORA ** -0.5),
        'rwkv_k_k': 0.85 + nrm((N_A, D), 0.05),
        'rwkv_k_a': 1.0 + nrm((N_A, D), 0.05),
        'rwkv_r_k': nrm((N_A, RW_HEADS, RW_HEAD), 0.1),
        'rwkv_ln_w': 1.0 + nrm((N_A, D), 0.05),
        'rwkv_ln_b': nrm((N_A, D), 0.02),
        'rwkv_w_o': nrm((N_A, D, D), D ** -0.5),
        'mamba_in_proj': nrm((N_B, D, M_IN_DIM), D ** -0.5),
        'mamba_conv_w': nrm((N_B, M_CONV, M_CONV_DIM), M_CONV ** -0.5),
        'mamba_conv_b': nrm((N_B, M_CONV_DIM), 0.02),
        'mamba_dt_bias': dt0 + jnp.log(-jnp.expm1(-dt0)),
        'mamba_a_log': jnp.log(unif((N_B, M_HEADS), 1.0, 16.0)),
        'mamba_d': 1.0 + nrm((N_B, M_HEADS), 0.05),
        'mamba_norm_w': 1.0 + nrm((N_B, M_D_INNER), 0.05),
        'mamba_out_proj': nrm((N_B, M_D_INNER, D), M_D_INNER ** -0.5),
        'peer_w_q': nrm((DEPTH, D, P_HEADS * P_QDIM), D ** -0.5),
        'peer_sub_keys': nrm((DEPTH, 2, P_HEADS, P_NKEYS, P_QDIM // 2), (P_QDIM // 2) ** -0.5),
        'peer_u': nrm((DEPTH, P_EXPERTS, D), D ** -0.5),
        'peer_v': nrm((DEPTH, P_EXPERTS, D), (P_HEADS * P_TOPK) ** -0.5),
    }


def reference(x_prompt, x_sample, state_rwkv_shift, state_rwkv_wkv, state_mamba_conv, state_mamba_ssm,
              meta_tokens, norm_mix, norm_ffn, norm_final,
              rwkv_mix, rwkv_w_rkv, rwkv_w0, rwkv_w1, rwkv_w2, rwkv_a0, rwkv_a1, rwkv_a2,
              rwkv_g1, rwkv_g2, rwkv_k_k, rwkv_k_a, rwkv_r_k, rwkv_ln_w, rwkv_ln_b, rwkv_w_o,
              mamba_in_proj, mamba_conv_w, mamba_conv_b, mamba_dt_bias, mamba_a_log, mamba_d,
              mamba_norm_w, mamba_out_proj,
              peer_w_q, peer_sub_keys, peer_u, peer_v):

    def trunk(h, shift0, wkv0, conv0, ssm0, lead_pad, chunk):
        shifts, wkvs, convs, ssms = [], [], [], []
        for i in range(DEPTH):
            xn = rms_norm(h, norm_mix[i])
            j = i // 2
            if i % 2 == 0:
                out, s_new, wkv_new = rwkv7_time_mix(
                    xn, shift0[j], wkv0[j], rwkv_mix[j], rwkv_w_rkv[j], rwkv_w0[j], rwkv_w1[j],
                    rwkv_w2[j], rwkv_a0[j], rwkv_a1[j], rwkv_a2[j], rwkv_g1[j], rwkv_g2[j],
                    rwkv_k_k[j], rwkv_k_a[j], rwkv_r_k[j], rwkv_ln_w[j], rwkv_ln_b[j], rwkv_w_o[j])
                shifts.append(s_new)
                wkvs.append(wkv_new)
            else:
                out, c_new, ssm_new = mamba2_mix(
                    xn, conv0[j], ssm0[j], mamba_in_proj[j], mamba_conv_w[j], mamba_conv_b[j],
                    mamba_dt_bias[j], mamba_a_log[j], mamba_d[j], mamba_norm_w[j], mamba_out_proj[j],
                    lead_pad, chunk)
                convs.append(c_new)
                ssms.append(ssm_new)
            h = h + out
            h = h + peer_ffn(rms_norm(h, norm_ffn[i]), peer_w_q[i], peer_sub_keys[i], peer_u[i], peer_v[i])
        return (rms_norm(h, norm_final), jnp.stack(shifts), jnp.stack(wkvs),
                jnp.stack(convs), jnp.stack(ssms))

    bp = x_prompt.shape[0]
    dtp = x_prompt.dtype
    meta = jnp.broadcast_to(meta_tokens.astype(dtp)[None], (bp, N_META, D_MODEL))
    hp = jnp.concatenate([meta, x_prompt], axis=1)
    z_shift = jnp.zeros((N_A, bp, D_MODEL), dtp)
    z_wkv = jnp.zeros((N_A, bp, RW_HEADS, RW_HEAD, RW_HEAD), dtp)
    z_conv = jnp.zeros((N_B, bp, M_CONV - 1, M_CONV_DIM), dtp)
    z_ssm = jnp.zeros((N_B, bp, M_HEADS, M_HEADDIM, M_STATE), dtp)
    yp, p_shift, p_wkv, p_conv, p_ssm = trunk(hp, z_shift, z_wkv, z_conv, z_ssm,
                                              M_CHUNK - N_META, M_CHUNK)
    ys, s_shift, s_wkv, s_conv, s_ssm = trunk(x_sample, state_rwkv_shift, state_rwkv_wkv,
                                              state_mamba_conv, state_mamba_ssm, 0, x_sample.shape[1])
    return (yp[:, N_META:], ys, p_shift, p_wkv, p_conv, p_ssm, s_shift, s_wkv, s_conv, s_ssm)
```

```cpp
#include <hip/hip_runtime.h>
#include <hip/hip_cooperative_groups.h>
#include <stdint.h>
#include <stdio.h>
namespace cg = cooperative_groups;

#ifndef PROBE
#define PROBE 0
#endif
#ifndef MK_MULTI
#define MK_MULTI 0
#endif

typedef unsigned short bf16_t;
typedef short bf16x8 __attribute__((ext_vector_type(8)));
typedef float f32x16 __attribute__((ext_vector_type(16)));
typedef float f32x2_t __attribute__((ext_vector_type(2)));
typedef __bf16 bf16x2_t __attribute__((ext_vector_type(2)));

#define DM 1024
#define LP 2064
#define TP 16512
#define TS 512
#define TT 17024
#define NPHASE 20

#define OUT0 0
#define OUT1 16777216
#define OUT2 17301504
#define OUT3 17309696
#define OUT4 17833984
#define OUT5 17907712
#define OUT6 20004864
#define OUT7 20135936
#define OUT8 28524544
#define OUT9 29704192

constexpr size_t UB = 34865152ull;
constexpr size_t OFF_H = 0;
constexpr size_t OFF_TAB = OFF_H + 2 * UB;
constexpr size_t OFF_WT = OFF_TAB + 67108864ull;
constexpr size_t WT_RKV = OFF_WT;
constexpr size_t WT_W1 = WT_RKV + 6291456;
constexpr size_t WT_A1 = WT_W1 + 131072;
constexpr size_t WT_G1 = WT_A1 + 131072;
constexpr size_t WT_W2 = WT_G1 + 393216;
constexpr size_t WT_A2 = WT_W2 + 131072;
constexpr size_t WT_G2 = WT_A2 + 131072;
constexpr size_t WT_WO = WT_G2 + 393216;
constexpr size_t WT_IN = WT_WO + 2097152;
constexpr size_t WT_OUT = WT_IN + 10551296;
constexpr size_t WT_Q = WT_OUT + 4194304;
constexpr size_t WT_SK = WT_Q + 8388608;
constexpr size_t WT_SH0 = WT_SK + 1048576;
constexpr size_t WT_ZERO = WT_SH0 + 262144;
constexpr size_t WT_SC = WT_ZERO + 2048;
constexpr size_t OFF_ARENA = OFF_WT + 34603008ull;
constexpr size_t RG(int i) { return OFF_ARENA + (size_t)i * UB; }
constexpr size_t OFF_L1W = RG(8);
constexpr size_t OFF_L1A = OFF_L1W + 2179072;
constexpr size_t OFF_L1G = OFF_L1A + 2179072;
constexpr size_t OFF_DTR = OFF_L1G + 6537216;
constexpr size_t OFF_BAR = OFF_DTR + 2179072;
constexpr size_t OFF_BON = OFF_BAR + 16384;
constexpr size_t OFF_BB = OFF_BON + 1089536;
constexpr size_t OFF_XC = OFF_BB;
constexpr size_t OFF_RSM = OFF_BB + UB;
constexpr size_t RSM_ITEM = 2304;
constexpr size_t OFF_RSP = OFF_RSM + 18560 * RSM_ITEM;
constexpr size_t WS_NEED = OFF_BB + 3 * UB;
static_assert(OFF_RSP + 2048ull * 10240 <= OFF_BB + 3 * UB, "rwkv packed region");
constexpr size_t OFF_XN = RG(0);
constexpr size_t OFF_Y = RG(0);
constexpr size_t OFF_R = RG(1), OFF_K = RG(2), OFF_V = RG(3);
constexpr size_t OFF_DEC = RG(4);
constexpr size_t OFF_A = RG(6), OFF_G = RG(7);
constexpr size_t OFF_XN2_0 = RG(1);
constexpr size_t OFF_KEYS_0 = RG(2);
constexpr size_t OFF_XNM = RG(0);
constexpr size_t OFF_Z = RG(1);
constexpr size_t OFF_XBC = RG(3);
constexpr size_t OFF_Y2 = RG(6);
constexpr size_t OFF_YG = RG(3);
constexpr size_t OFF_XN2_1 = RG(5);
constexpr size_t OFF_KEYS_1 = RG(0);

struct Params {
  const float* in[38];
  float* out;
  char* ws;
  int phase_lo, phase_hi;
};

__device__ __forceinline__ unsigned cvtpk(float lo, float hi) {
  f32x2_t v = {lo, hi};
  bf16x2_t b = __builtin_convertvector(v, bf16x2_t);
  return __builtin_bit_cast(unsigned, b);
}
__device__ __forceinline__ float bflo(unsigned u) { return __uint_as_float(u << 16); }
__device__ __forceinline__ float bfhi(unsigned u) { return __uint_as_float(u & 0xffff0000u); }
__device__ __forceinline__ float bf2f(bf16_t b) { return __uint_as_float(((unsigned)b) << 16); }
__device__ __forceinline__ bf16_t f2bf(float f) { return (bf16_t)(cvtpk(f, 0.f) & 0xffffu); }
__device__ __forceinline__ float dot2bf(unsigned a, unsigned b, float c) {
  return __builtin_amdgcn_fdot2_f32_bf16(__builtin_bit_cast(bf16x2_t, a), __builtin_bit_cast(bf16x2_t, b), c, false);
}
template <int CTRL> __device__ __forceinline__ float dpp_f(float v) {
  return __int_as_float(__builtin_amdgcn_update_dpp(0, __float_as_int(v), CTRL, 0xf, 0xf, true));
}
template <int CTRL> __device__ __forceinline__ int dpp_i(int v) {
  return __builtin_amdgcn_update_dpp(0, v, CTRL, 0xf, 0xf, true);
}
__device__ __forceinline__ float quad_sum(float v) { v += dpp_f<0xB1>(v); v += dpp_f<0x4E>(v); return v; }
__device__ __forceinline__ float oct_sum(float v) { v = quad_sum(v); v += dpp_f<0x141>(v); return v; }
__device__ __forceinline__ float row_sum(float v) { v = oct_sum(v); v += dpp_f<0x140>(v); return v; }
__device__ __forceinline__ float rdlane(float v, int l) { return __int_as_float(__builtin_amdgcn_readlane(__float_as_int(v), l)); }
__device__ __forceinline__ float wave_sum(float v) {
  v = row_sum(v);
  return (rdlane(v, 0) + rdlane(v, 16)) + (rdlane(v, 32) + rdlane(v, 48));
}
__device__ __forceinline__ float wave_max(float v) {
  v = fmaxf(v, dpp_f<0xB1>(v)); v = fmaxf(v, dpp_f<0x4E>(v)); v = fmaxf(v, dpp_f<0x141>(v)); v = fmaxf(v, dpp_f<0x140>(v));
  return fmaxf(fmaxf(rdlane(v, 0), rdlane(v, 16)), fmaxf(rdlane(v, 32), rdlane(v, 48)));
}
__device__ __forceinline__ float sigmoidf_(float x) { return 1.f / (1.f + __expf(-x)); }
__device__ __forceinline__ float softplusf_(float x) { return fmaxf(x, 0.f) + log1pf(__expf(-fabsf(x))); }
__device__ __forceinline__ int enc_key(float s) { int i = __float_as_int(s); return i ^ ((i >> 31) & 0x7fffffff); }
__device__ __forceinline__ float dec_key(int i) { return __int_as_float(i ^ ((i >> 31) & 0x7fffffff)); }

__device__ __forceinline__ void unpack8(const uint4 u, float (&f)[8]) {
  f[0] = bflo(u.x); f[1] = bfhi(u.x); f[2] = bflo(u.y); f[3] = bfhi(u.y); f[4] = bflo(u.z); f[5] = bfhi(u.z); f[6] = bflo(u.w); f[7] = bfhi(u.w);
}
__device__ __forceinline__ uint4 pack8(const float (&f)[8]) {
  return make_uint4(cvtpk(f[0], f[1]), cvtpk(f[2], f[3]), cvtpk(f[4], f[5]), cvtpk(f[6], f[7]));
}
#define INS16(L, x_)                          \
  {                                           \
    int xx = (x_);                            \
    _Pragma("unroll") for (int q_ = 0; q_ < 16; q_++) { \
      int hi_ = max(L[q_], xx);               \
      xx = min(L[q_], xx);                    \
      L[q_] = hi_;                            \
    }                                         \
  }

__device__ __forceinline__ void sort16_desc(int (&a)[16]) {
  { const int hi_ = max(a[0], a[1]), lo_ = min(a[0], a[1]); a[0] = hi_; a[1] = lo_; }
  { const int hi_ = max(a[2], a[3]), lo_ = min(a[2], a[3]); a[2] = lo_; a[3] = hi_; }
  { const int hi_ = max(a[4], a[5]), lo_ = min(a[4], a[5]); a[4] = hi_; a[5] = lo_; }
  { const int hi_ = max(a[6], a[7]), lo_ = min(a[6], a[7]); a[6] = lo_; a[7] = hi_; }
  { const int hi_ = max(a[8], a[9]), lo_ = min(a[8], a[9]); a[8] = hi_; a[9] = lo_; }
  { const int hi_ = max(a[10], a[11]), lo_ = min(a[10], a[11]); a[10] = lo_; a[11] = hi_; }
  { const int hi_ = max(a[12], a[13]), lo_ = min(a[12], a[13]); a[12] = hi_; a[13] = lo_; }
  { const int hi_ = max(a[14], a[15]), lo_ = min(a[14], a[15]); a[14] = lo_; a[15] = hi_; }
  { const int hi_ = max(a[0], a[2]), lo_ = min(a[0], a[2]); a[0] = hi_; a[2] = lo_; }
  { const int hi_ = max(a[1], a[3]), lo_ = min(a[1], a[3]); a[1] = hi_; a[3] = lo_; }
  { const int hi_ = max(a[4], a[6]), lo_ = min(a[4], a[6]); a[4] = lo_; a[6] = hi_; }
  { const int hi_ = max(a[5], a[7]), lo_ = min(a[5], a[7]); a[5] = lo_; a[7] = hi_; }
  { const int hi_ = max(a[8], a[10]), lo_ = min(a[8], a[10]); a[8] = hi_; a[10] = lo_; }
  { const int hi_ = max(a[9], a[11]), lo_ = min(a[9], a[11]); a[9] = hi_; a[11] = lo_; }
  { const int hi_ = max(a[12], a[14]), lo_ = min(a[12], a[14]); a[12] = lo_; a[14] = hi_; }
  { const int hi_ = max(a[13], a[15]), lo_ = min(a[13], a[15]); a[13] = lo_; a[15] = hi_; }
  { const int hi_ = max(a[0], a[1]), lo_ = min(a[0], a[1]); a[0] = hi_; a[1] = lo_; }
  { const int hi_ = max(a[2], a[3]), lo_ = min(a[2], a[3]); a[2] = hi_; a[3] = lo_; }
  { const int hi_ = max(a[4], a[5]), lo_ = min(a[4], a[5]); a[4] = lo_; a[5] = hi_; }
  { const int hi_ = max(a[6], a[7]), lo_ = min(a[6], a[7]); a[6] = lo_; a[7] = hi_; }
  { const int hi_ = max(a[8], a[9]), lo_ = min(a[8], a[9]); a[8] = hi_; a[9] = lo_; }
  { const int hi_ = max(a[10], a[11]), lo_ = min(a[10], a[11]); a[10] = hi_; a[11] = lo_; }
  { const int hi_ = max(a[12], a[13]), lo_ = min(a[12], a[13]); a[12] = lo_; a[13] = hi_; }
  { const int hi_ = max(a[14], a[15]), lo_ = min(a[14], a[15]); a[14] = lo_; a[15] = hi_; }
  { const int hi_ = max(a[0], a[4]), lo_ = min(a[0], a[4]); a[0] = hi_; a[4] = lo_; }
  { const int hi_ = max(a[1], a[5]), lo_ = min(a[1], a[5]); a[1] = hi_; a[5] = lo_; }
  { const int hi_ = max(a[2], a[6]), lo_ = min(a[2], a[6]); a[2] = hi_; a[6] = lo_; }
  { const int hi_ = max(a[3], a[7]), lo_ = min(a[3], a[7]); a[3] = hi_; a[7] = lo_; }
  { const int hi_ = max(a[8], a[12]), lo_ = min(a[8], a[12]); a[8] = lo_; a[12] = hi_; }
  { const int hi_ = max(a[9], a[13]), lo_ = min(a[9], a[13]); a[9] = lo_; a[13] = hi_; }
  { const int hi_ = max(a[10], a[14]), lo_ = min(a[10], a[14]); a[10] = lo_; a[14] = hi_; }
  { const int hi_ = max(a[11], a[15]), lo_ = min(a[11], a[15]); a[11] = lo_; a[15] = hi_; }
  { const int hi_ = max(a[0], a[2]), lo_ = min(a[0], a[2]); a[0] = hi_; a[2] = lo_; }
  { const int hi_ = max(a[1], a[3]), lo_ = min(a[1], a[3]); a[1] = hi_; a[3] = lo_; }
  { const int hi_ = max(a[4], a[6]), lo_ = min(a[4], a[6]); a[4] = hi_; a[6] = lo_; }
  { const int hi_ = max(a[5], a[7]), lo_ = min(a[5], a[7]); a[5] = hi_; a[7] = lo_; }
  { const int hi_ = max(a[8], a[10]), lo_ = min(a[8], a[10]); a[8] = lo_; a[10] = hi_; }
  { const int hi_ = max(a[9], a[11]), lo_ = min(a[9], a[11]); a[9] = lo_; a[11] = hi_; }
  { const int hi_ = max(a[12], a[14]), lo_ = min(a[12], a[14]); a[12] = lo_; a[14] = hi_; }
  { const int hi_ = max(a[13], a[15]), lo_ = min(a[13], a[15]); a[13] = lo_; a[15] = hi_; }
  { const int hi_ = max(a[0], a[1]), lo_ = min(a[0], a[1]); a[0] = hi_; a[1] = lo_; }
  { const int hi_ = max(a[2], a[3]), lo_ = min(a[2], a[3]); a[2] = hi_; a[3] = lo_; }
  { const int hi_ = max(a[4], a[5]), lo_ = min(a[4], a[5]); a[4] = hi_; a[5] = lo_; }
  { const int hi_ = max(a[6], a[7]), lo_ = min(a[6], a[7]); a[6] = hi_; a[7] = lo_; }
  { const int hi_ = max(a[8], a[9]), lo_ = min(a[8], a[9]); a[8] = lo_; a[9] = hi_; }
  { const int hi_ = max(a[10], a[11]), lo_ = min(a[10], a[11]); a[10] = lo_; a[11] = hi_; }
  { const int hi_ = max(a[12], a[13]), lo_ = min(a[12], a[13]); a[12] = lo_; a[13] = hi_; }
  { const int hi_ = max(a[14], a[15]), lo_ = min(a[14], a[15]); a[14] = lo_; a[15] = hi_; }
  { const int hi_ = max(a[0], a[8]), lo_ = min(a[0], a[8]); a[0] = hi_; a[8] = lo_; }
  { const int hi_ = max(a[1], a[9]), lo_ = min(a[1], a[9]); a[1] = hi_; a[9] = lo_; }
  { const int hi_ = max(a[2], a[10]), lo_ = min(a[2], a[10]); a[2] = hi_; a[10] = lo_; }
  { const int hi_ = max(a[3], a[11]), lo_ = min(a[3], a[11]); a[3] = hi_; a[11] = lo_; }
  { const int hi_ = max(a[4], a[12]), lo_ = min(a[4], a[12]); a[4] = hi_; a[12] = lo_; }
  { const int hi_ = max(a[5], a[13]), lo_ = min(a[5], a[13]); a[5] = hi_; a[13] = lo_; }
  { const int hi_ = max(a[6], a[14]), lo_ = min(a[6], a[14]); a[6] = hi_; a[14] = lo_; }
  { const int hi_ = max(a[7], a[15]), lo_ = min(a[7], a[15]); a[7] = hi_; a[15] = lo_; }
  { const int hi_ = max(a[0], a[4]), lo_ = min(a[0], a[4]); a[0] = hi_; a[4] = lo_; }
  { const int hi_ = max(a[1], a[5]), lo_ = min(a[1], a[5]); a[1] = hi_; a[5] = lo_; }
  { const int hi_ = max(a[2], a[6]), lo_ = min(a[2], a[6]); a[2] = hi_; a[6] = lo_; }
  { const int hi_ = max(a[3], a[7]), lo_ = min(a[3], a[7]); a[3] = hi_; a[7] = lo_; }
  { const int hi_ = max(a[8], a[12]), lo_ = min(a[8], a[12]); a[8] = hi_; a[12] = lo_; }
  { const int hi_ = max(a[9], a[13]), lo_ = min(a[9], a[13]); a[9] = hi_; a[13] = lo_; }
  { const int hi_ = max(a[10], a[14]), lo_ = min(a[10], a[14]); a[10] = hi_; a[14] = lo_; }
  { const int hi_ = max(a[11], a[15]), lo_ = min(a[11], a[15]); a[11] = hi_; a[15] = lo_; }
  { const int hi_ = max(a[0], a[2]), lo_ = min(a[0], a[2]); a[0] = hi_; a[2] = lo_; }
  { const int hi_ = max(a[1], a[3]), lo_ = min(a[1], a[3]); a[1] = hi_; a[3] = lo_; }
  { const int hi_ = max(a[4], a[6]), lo_ = min(a[4], a[6]); a[4] = hi_; a[6] = lo_; }
  { const int hi_ = max(a[5], a[7]), lo_ = min(a[5], a[7]); a[5] = hi_; a[7] = lo_; }
  { const int hi_ = max(a[8], a[10]), lo_ = min(a[8], a[10]); a[8] = hi_; a[10] = lo_; }
  { const int hi_ = max(a[9], a[11]), lo_ = min(a[9], a[11]); a[9] = hi_; a[11] = lo_; }
  { const int hi_ = max(a[12], a[14]), lo_ = min(a[12], a[14]); a[12] = hi_; a[14] = lo_; }
  { const int hi_ = max(a[13], a[15]), lo_ = min(a[13], a[15]); a[13] = hi_; a[15] = lo_; }
  { const int hi_ = max(a[0], a[1]), lo_ = min(a[0], a[1]); a[0] = hi_; a[1] = lo_; }
  { const int hi_ = max(a[2], a[3]), lo_ = min(a[2], a[3]); a[2] = hi_; a[3] = lo_; }
  { const int hi_ = max(a[4], a[5]), lo_ = min(a[4], a[5]); a[4] = hi_; a[5] = lo_; }
  { const int hi_ = max(a[6], a[7]), lo_ = min(a[6], a[7]); a[6] = hi_; a[7] = lo_; }
  { const int hi_ = max(a[8], a[9]), lo_ = min(a[8], a[9]); a[8] = hi_; a[9] = lo_; }
  { const int hi_ = max(a[10], a[11]), lo_ = min(a[10], a[11]); a[10] = hi_; a[11] = lo_; }
  { const int hi_ = max(a[12], a[13]), lo_ = min(a[12], a[13]); a[12] = hi_; a[13] = lo_; }
  { const int hi_ = max(a[14], a[15]), lo_ = min(a[14], a[15]); a[14] = hi_; a[15] = lo_; }
}
__device__ __forceinline__ void merge16_desc(int (&L)[16], const int (&b)[16]) {
#pragma unroll
  for (int j = 0; j < 16; j++) L[j] = max(L[j], b[15 - j]);
#define MSTAGE(d_)                                                                                          \
  _Pragma("unroll") for (int j = 0; j < 16; j++) if ((j & (d_)) == 0) {                                    \
    const int hi = max(L[j], L[j + (d_)]), lo = min(L[j], L[j + (d_)]); L[j] = hi; L[j + (d_)] = lo; }
  MSTAGE(8) MSTAGE(4) MSTAGE(2) MSTAGE(1)
#undef MSTAGE
}

__device__ __forceinline__ void transpose_job(const float* __restrict__ src, int K, int N, bf16_t* __restrict__ dst, int ldk,
                              int nrows, float* tile, int rot, int vb = -1, int vnb = 0) {
  const int tid = threadIdx.x;
  const int tk = ldk / 64, tn = (nrows + 63) / 64;
  const int nb = (vb < 0) ? (int)gridDim.x : vnb;
  const int bid = (((vb < 0) ? (int)blockIdx.x : vb) + rot) % nb;
  for (int tix = bid; tix < tk * tn; tix += nb) {
    const int k0 = (tix % tk) * 64, n0 = (tix / tk) * 64;
#pragma unroll
    for (int i = 0; i < 4; i++) {
      const int kl = (tid >> 4) + 16 * i, nl = (tid & 15) * 4;
      const int k = k0 + kl, n = n0 + nl;
      float4 v = make_float4(0.f, 0.f, 0.f, 0.f);
      if (k < K && n < N) v = *(const float4*)(src + (size_t)k * N + n);
      float* tp = tile + kl * 65 + nl;
      tp[0] = v.x; tp[1] = v.y; tp[2] = v.z; tp[3] = v.w;
    }
    __syncthreads();
    {
      const int nl = tid >> 2, kq = tid & 3;
      const int n = n0 + nl;
      if (n < nrows) {
        unsigned w[8];
#pragma unroll
        for (int j = 0; j < 8; j++)
          w[j] = cvtpk(tile[(kq * 16 + 2 * j) * 65 + nl], tile[(kq * 16 + 2 * j + 1) * 65 + nl]);
        uint4* dp = (uint4*)(dst + (size_t)n * ldk + k0 + kq * 16);
        dp[0] = make_uint4(w[0], w[1], w[2], w[3]);
        dp[1] = make_uint4(w[4], w[5], w[6], w[7]);
      }
    }
    __syncthreads();
  }
}

__device__ __forceinline__ void convert_linear(const float* __restrict__ src, bf16_t* __restrict__ dst, size_t n8, bool nt, int vb = -1, int vnb = 0) {
  typedef float f32x4n __attribute__((ext_vector_type(4)));
  const f32x4n* s = (const f32x4n*)src;
  uint4* d = (uint4*)dst;
  const size_t stride = (size_t)((vb < 0) ? (int)gridDim.x : vnb) * 256;
  for (size_t i = (size_t)((vb < 0) ? (int)blockIdx.x : vb) * 256 + threadIdx.x; i < n8; i += stride) {
    f32x4n a, b;
    if (nt) {
      a = __builtin_nontemporal_load(s + 2 * i);
      b = __builtin_nontemporal_load(s + 2 * i + 1);
    } else {
      a = s[2 * i]; b = s[2 * i + 1];
    }
    d[i] = make_uint4(cvtpk(a.x, a.y), cvtpk(a.z, a.w), cvtpk(b.x, b.y), cvtpk(b.z, b.w));
  }
}

__device__ __forceinline__ void convert_tables_fp8(const Params& p, int vb, int vnb, int layer) {
  typedef float f32x4n __attribute__((ext_vector_type(4)));
  const int lane = threadIdx.x & 63, wave = threadIdx.x >> 6;
  uint2* tab = (uint2*)(p.ws + OFF_TAB);
  float* sc = (float*)(p.ws + WT_SC);
  for (int r = layer * 32768 + vb * 4 + wave; r < (layer + 1) * 32768; r += vnb * 4) {
    const int which = r >> 14, row = r & 16383;
    const float* src = ((which & 1) ? p.in[37] : p.in[36]) + (size_t)(which >> 1) * 16777216 + (size_t)row * 1024;
    f32x4n v[4]; float am = 0.f;
#pragma unroll
    for (int i = 0; i < 4; i++) {
      v[i] = __builtin_nontemporal_load((const f32x4n*)src + lane * 4 + i);
      am = fmaxf(am, fmaxf(fmaxf(fabsf(v[i].x), fabsf(v[i].y)), fmaxf(fabsf(v[i].z), fabsf(v[i].w))));
    }
    am = wave_max(am);
    const float scale = am > 0.f ? 6.f / am : 0.f;
    unsigned w0 = 0, w1 = 0;
    w0 = __builtin_amdgcn_cvt_scalef32_pk_fp4_f32(w0, v[0].x * scale, v[0].y * scale, 1.0f, 0);
    w0 = __builtin_amdgcn_cvt_scalef32_pk_fp4_f32(w0, v[0].z * scale, v[0].w * scale, 1.0f, 1);
    w0 = __builtin_amdgcn_cvt_scalef32_pk_fp4_f32(w0, v[1].x * scale, v[1].y * scale, 1.0f, 2);
    w0 = __builtin_amdgcn_cvt_scalef32_pk_fp4_f32(w0, v[1].z * scale, v[1].w * scale, 1.0f, 3);
    w1 = __builtin_amdgcn_cvt_scalef32_pk_fp4_f32(w1, v[2].x * scale, v[2].y * scale, 1.0f, 0);
    w1 = __builtin_amdgcn_cvt_scalef32_pk_fp4_f32(w1, v[2].z * scale, v[2].w * scale, 1.0f, 1);
    w1 = __builtin_amdgcn_cvt_scalef32_pk_fp4_f32(w1, v[3].x * scale, v[3].y * scale, 1.0f, 2);
    w1 = __builtin_amdgcn_cvt_scalef32_pk_fp4_f32(w1, v[3].z * scale, v[3].w * scale, 1.0f, 3);
    tab[(size_t)r * 64 + lane] = make_uint2(w0, w1);
    if (lane == 0) sc[r] = am * (1.f / 6.f);
  }
}

__device__ __forceinline__ void phase0(const Params& p, char* smem) {
  const int tid = threadIdx.x, lane = tid & 63, wave = tid >> 6;
  const int nb = gridDim.x, bid = blockIdx.x;
  {
    float* H = (float*)(p.ws + OFF_H);
    bf16_t* XN = (bf16_t*)(p.ws + OFF_XN);
    const float4* g0 = (const float4*)p.in[7];
    for (int t = bid * 4 + wave; t < TT; t += nb * 4) {
      const float* src; int b, l;
      if (t < TP) {
        b = t / LP; l = t - b * LP;
        src = (l < 16) ? (p.in[6] + l * DM) : (p.in[0] + ((size_t)b * 2048 + (l - 16)) * DM);
      } else {
        int s = t - TP; b = s >> 2; l = s & 3; src = p.in[1] + (size_t)s * DM;
      }
      float4 v[4]; float ss = 0.f;
#pragma unroll
      for (int i = 0; i < 4; i++) {
        v[i] = ((const float4*)src)[i * 64 + lane];
        ss += v[i].x * v[i].x + v[i].y * v[i].y + v[i].z * v[i].z + v[i].w * v[i].w;
      }
      ss = wave_sum(ss);
      const float rstd = rsqrtf(ss * (1.f / 1024.f) + 1e-5f);
      float* sdst = nullptr;
      if (t < TP) { if (l == LP - 1) sdst = p.out + OUT2 + b * DM; }
      else if (l == 3) sdst = p.out + OUT6 + b * DM;
#pragma unroll
      for (int i = 0; i < 4; i++) {
        const float4 g = g0[i * 64 + lane];
        ((float4*)(H + (size_t)t * DM))[i * 64 + lane] = v[i];
        float4 xn = make_float4(v[i].x * rstd * g.x, v[i].y * rstd * g.y, v[i].z * rstd * g.z, v[i].w * rstd * g.w);
        ((uint2*)(XN + (size_t)t * DM))[i * 64 + lane] = make_uint2(cvtpk(xn.x, xn.y), cvtpk(xn.z, xn.w));
        if (sdst) ((float4*)sdst)[i * 64 + lane] = xn;
      }
    }
  }
  float* tile = (float*)smem;
  char* ws = p.ws;
  for (int j = 0; j < 3; j++)
    transpose_job(p.in[11] + (size_t)j * 1048576, 1024, 1024, (bf16_t*)(ws + WT_RKV) + (size_t)j * 1048576, 1024, 1024, tile, j * 37);
  transpose_job(p.in[13], 1024, 64, (bf16_t*)(ws + WT_W1), 1024, 64, tile, 11);
  transpose_job(p.in[16], 1024, 64, (bf16_t*)(ws + WT_A1), 1024, 64, tile, 29);
  transpose_job(p.in[18], 1024, 160, (bf16_t*)(ws + WT_G1), 1024, 192, tile, 47);
  transpose_job(p.in[14], 64, 1024, (bf16_t*)(ws + WT_W2), 64, 1024, tile, 95);
  transpose_job(p.in[17], 64, 1024, (bf16_t*)(ws + WT_A2), 64, 1024, tile, 111);
  transpose_job(p.in[19], 160, 1024, (bf16_t*)(ws + WT_G2), 192, 1024, tile, 127);

  convert_linear(p.in[2], (bf16_t*)(ws + WT_SH0), 16384, false);
  if (bid == nb - 1 && tid < 128) ((uint4*)(ws + WT_ZERO))[tid] = make_uint4(0, 0, 0, 0);
}

#define SAS 72
struct GemmA {
  const bf16_t* A; int lda;
  const float* mix; const bf16_t* sh0; const bf16_t* zero;
};

template <int MIX, int SWAP = 0>
__device__ __forceinline__ void gemm_mainloop(f32x16 (&acc)[2][2], const GemmA& ga, const bf16_t* __restrict__ Bt,
                                              int ldb, int Nvalid, int K, int m0, int n0, bf16_t* sA, bf16_t* sB) {
  const int tid = threadIdx.x, lane = tid & 63, wave = tid >> 6;
  const int wm = wave >> 1, wn = wave & 1;
  const int lrow = tid >> 3, kc = tid & 7;
#pragma unroll
  for (int i = 0; i < 2; i++)
#pragma unroll
    for (int j = 0; j < 2; j++)
#pragma unroll
      for (int r = 0; r < 16; r++) acc[i][j][r] = 0.f;
  const bf16_t* arow[4]; const bf16_t* prow[4]; const bf16_t* brow[4]; bool bval[4];
#pragma unroll
  for (int i = 0; i < 4; i++) {
    const int t = m0 + lrow + 32 * i;
    arow[i] = ga.A + (size_t)t * ga.lda + kc * 8;
    prow[i] = arow[i];
    if (MIX) {
      int b, l;
      if (t < TP) { b = t / LP; l = t - b * LP; } else { int s = t - TP; b = s >> 2; l = s & 3; }
      const bf16_t* pr = (l == 0) ? ((t < TP) ? ga.zero : (ga.sh0 + b * DM)) : (ga.A + (size_t)(t - 1) * ga.lda);
      prow[i] = pr + kc * 8;
    }
    const int n = n0 + lrow + 32 * i;
    bval[i] = n < Nvalid;
    brow[i] = Bt + (size_t)(bval[i] ? n : 0) * ldb + kc * 8;
  }
  uint4 rx0[4], rp0[4], rb0[4], rx1[4], rp1[4], rb1[4];
#define GLOAD(RX, RP, RB, k0_)                                                      \
  {                                                                                 \
    _Pragma("unroll") for (int i = 0; i < 4; i++) {                                 \
      RX[i] = *(const uint4*)(arow[i] + (k0_));                                     \
      if (MIX) RP[i] = *(const uint4*)(prow[i] + (k0_));                            \
      RB[i] = bval[i] ? *(const uint4*)(brow[i] + (k0_)) : make_uint4(0, 0, 0, 0);  \
    }                                                                               \
  }
#define GSTORE(RX, RP, RB, k0_, dA_, dB_)                                           \
  {                                                                                 \
    float4 MA, MB;                                                                  \
    if (MIX) { MA = *(const float4*)(ga.mix + (k0_) + kc * 8); MB = *(const float4*)(ga.mix + (k0_) + kc * 8 + 4); } \
    _Pragma("unroll") for (int i = 0; i < 4; i++) {                                 \
      uint4 v = RX[i];                                                              \
      if (MIX) {                                                                    \
        const uint4 x = RX[i], q = RP[i];                                           \
        float xl, xh, pl, ph;                                                       \
        xl = bflo(x.x); xh = bfhi(x.x); pl = bflo(q.x); ph = bfhi(q.x);             \
        v.x = cvtpk(xl + (pl - xl) * MA.x, xh + (ph - xh) * MA.y);                  \
        xl = bflo(x.y); xh = bfhi(x.y); pl = bflo(q.y); ph = bfhi(q.y);             \
        v.y = cvtpk(xl + (pl - xl) * MA.z, xh + (ph - xh) * MA.w);                  \
        xl = bflo(x.z); xh = bfhi(x.z); pl = bflo(q.z); ph = bfhi(q.z);             \
        v.z = cvtpk(xl + (pl - xl) * MB.x, xh + (ph - xh) * MB.y);                  \
        xl = bflo(x.w); xh = bfhi(x.w); pl = bflo(q.w); ph = bfhi(q.w);             \
        v.w = cvtpk(xl + (pl - xl) * MB.z, xh + (ph - xh) * MB.w);                  \
      }                                                                             \
      *(uint4*)((dA_) + (lrow + 32 * i) * SAS + kc * 8) = v;                        \
      *(uint4*)((dB_) + (lrow + 32 * i) * SAS + kc * 8) = RB[i];                    \
    }                                                                               \
  }
#define GCOMPUTE(cA_, cB_)                                                          \
  {                                                                                 \
    _Pragma("unroll") for (int ks = 0; ks < 4; ks++) {                              \
      bf16x8 a[2], b[2];                                                            \
      _Pragma("unroll") for (int i = 0; i < 2; i++) {                               \
        a[i] = *(const bf16x8*)((cA_) + (wm * 64 + i * 32 + (lane & 31)) * SAS + ks * 16 + (lane >> 5) * 8); \
        b[i] = *(const bf16x8*)((cB_) + (wn * 64 + i * 32 + (lane & 31)) * SAS + ks * 16 + (lane >> 5) * 8); \
      }                                                                             \
      _Pragma("unroll") for (int i = 0; i < 2; i++)                                 \
        _Pragma("unroll") for (int j = 0; j < 2; j++)                               \
          acc[i][j] = SWAP ? __builtin_amdgcn_mfma_f32_32x32x16_bf16(b[j], a[i], acc[i][j], 0, 0, 0) \
                           : __builtin_amdgcn_mfma_f32_32x32x16_bf16(a[i], b[j], acc[i][j], 0, 0, 0); \
    }                                                                               \
  }
  bf16_t* A0 = sA; bf16_t* B0 = sA + 128 * SAS;
  bf16_t* A1 = sA + 2 * 128 * SAS; bf16_t* B1 = A1 + 128 * SAS;
  const int nk = K >> 6;
  __syncthreads();
  GLOAD(rx0, rp0, rb0, 0);
  if (nk > 1) GLOAD(rx1, rp1, rb1, 64);
  GSTORE(rx0, rp0, rb0, 0, A0, B0);
  if (nk > 2) GLOAD(rx0, rp0, rb0, 128);
  __syncthreads();
  for (int t = 0; t < nk; t += 2) {
    if (t + 1 < nk) {
      GSTORE(rx1, rp1, rb1, (t + 1) * 64, A1, B1);
      if (t + 3 < nk) GLOAD(rx1, rp1, rb1, (t + 3) * 64);
    }
    GCOMPUTE(A0, B0);
    __syncthreads();
    if (t + 1 < nk) {
      if (t + 2 < nk) {
        GSTORE(rx0, rp0, rb0, (t + 2) * 64, A0, B0);
        if (t + 4 < nk) GLOAD(rx0, rp0, rb0, (t + 4) * 64);
      }
      GCOMPUTE(A1, B1);
      __syncthreads();
    }
  }
#undef GLOAD
#undef GSTORE
#undef GCOMPUTE
}

template <class F>
__device__ __forceinline__ void gemm_epilogue(const f32x16 (&acc)[2][2], int m0, int n0, F f) {
  const int tid = threadIdx.x, lane = tid & 63, wave = tid >> 6;
  const int wm = wave >> 1, wn = wave & 1;
#pragma unroll
  for (int i = 0; i < 2; i++)
#pragma unroll
    for (int j = 0; j < 2; j++)
#pragma unroll
      for (int r = 0; r < 16; r++) {
        const int row = m0 + wm * 64 + i * 32 + (lane >> 5) * 4 + (r & 3) + 8 * (r >> 2);
        const int col = n0 + wn * 64 + j * 32 + (lane & 31);
        f(row, col, acc[i][j][r]);
      }
}

template <class F>
__device__ __forceinline__ void gemm_epilogue_bf16_lds(const f32x16 (&acc)[2][2], bf16_t* __restrict__ out, size_t ld, int m0, int c0,
                                                       int ctile0, bf16_t* T, F f) {
  const int tid = threadIdx.x, lane = tid & 63, wave = tid >> 6;
  const int wm = wave >> 1, wn = wave & 1;
#pragma unroll
  for (int i = 0; i < 2; i++)
#pragma unroll
    for (int j = 0; j < 2; j++)
#pragma unroll
      for (int q = 0; q < 4; q++) {
        const int rowl = wm * 64 + i * 32 + (lane & 31);
        const int coll = wn * 64 + j * 32 + (lane >> 5) * 4 + 8 * q;
        const int cg = ctile0 + coll;
        *(uint2*)(T + rowl * 136 + coll) = make_uint2(cvtpk(f(cg, acc[i][j][4 * q]), f(cg + 1, acc[i][j][4 * q + 1])),
                                                      cvtpk(f(cg + 2, acc[i][j][4 * q + 2]), f(cg + 3, acc[i][j][4 * q + 3])));
      }
  __syncthreads();
#pragma unroll
  for (int k = 0; k < 8; k++) {
    const int c = tid + 256 * k;
    const int row = c >> 4, ch = c & 15;
    *(uint4*)(out + (size_t)(m0 + row) * ld + c0 + ch * 8) = *(const uint4*)(T + row * 136 + ch * 8);
  }
}

__device__ __forceinline__ void phase_rwkv_proj(const Params& p, char* smem) {
  bf16_t* sA = (bf16_t*)smem; bf16_t* sB = sA + 128 * SAS;
  char* ws = p.ws;
  int tile = blockIdx.x;
  for (; tile < 133 * 4; tile += gridDim.x) {
    const int tm = tile >> 2, jt = tile & 3;
    const int job = (jt == 0) ? 3 : (jt == 1) ? 4 : 5;
    const int tn = (jt == 3) ? 1 : 0;
    const int mixidx = (job == 3) ? 1 : (job == 4) ? 4 : 5;
    GemmA ga;
    ga.A = (const bf16_t*)(ws + OFF_XN); ga.lda = DM;
    ga.mix = p.in[10] + mixidx * DM;
    ga.sh0 = (const bf16_t*)(ws + WT_SH0); ga.zero = (const bf16_t*)(ws + WT_ZERO);
    const bf16_t* Bt; int Nv;
    if (job == 3) { Bt = (const bf16_t*)(ws + WT_W1); Nv = 64; }
    else if (job == 4) { Bt = (const bf16_t*)(ws + WT_A1); Nv = 64; }
    else { Bt = (const bf16_t*)(ws + WT_G1); Nv = 192; }
    f32x16 acc[2][2];
    gemm_mainloop<1>(acc, ga, Bt, 1024, Nv, 1024, tm * 128, tn * 128, sA, sB);
    if (job == 3) {
      bf16_t* o = (bf16_t*)(ws + OFF_L1W);
      gemm_epilogue(acc, tm * 128, 0, [&](int row, int col, float v) { if (col < 64) o[(size_t)row * 64 + col] = f2bf(tanhf(v)); });
    } else if (job == 4) {
      bf16_t* o = (bf16_t*)(ws + OFF_L1A);
      gemm_epilogue(acc, tm * 128, 0, [&](int row, int col, float v) { if (col < 64) o[(size_t)row * 64 + col] = f2bf(v); });
    } else {
      bf16_t* o = (bf16_t*)(ws + OFF_L1G);
      gemm_epilogue(acc, tm * 128, tn * 128, [&](int row, int col, float v) { if (col < 192) o[(size_t)row * 192 + col] = f2bf(sigmoidf_(v)); });
    }
  }
  for (; tile < 133 * 28; tile += gridDim.x) {
    const int t2 = tile - 133 * 4;
    const int tm = t2 / 24, jt = t2 - tm * 24;
    const int job = jt >> 3, tn = jt & 7;
    const int mixidx = (job == 0) ? 0 : (job == 1) ? 2 : 3;
    GemmA ga;
    ga.A = (const bf16_t*)(ws + OFF_XN); ga.lda = DM;
    ga.mix = p.in[10] + mixidx * DM;
    ga.sh0 = (const bf16_t*)(ws + WT_SH0); ga.zero = (const bf16_t*)(ws + WT_ZERO);
    const bf16_t* Bt = (const bf16_t*)(ws + WT_RKV) + (size_t)job * 1048576;
    f32x16 acc[2][2];
    gemm_mainloop<1, 1>(acc, ga, Bt, 1024, 1024, 1024, tm * 128, tn * 128, sA, sB);
    bf16_t* o = (bf16_t*)(ws + (job == 0 ? OFF_R : job == 1 ? OFF_K : OFF_V));
    gemm_epilogue_bf16_lds(acc, o, DM, tm * 128, tn * 128, tn * 128, sA, [&](int, float v) { return v; });
  }
}

__device__ __forceinline__ void phase_rwkv_lora2(const Params& p, char* smem) {
  bf16_t* sA = (bf16_t*)smem; bf16_t* sB = sA + 128 * SAS;
  char* ws = p.ws;
  for (int tile = blockIdx.x; tile < 133 * 24; tile += gridDim.x) {
    const int tm = tile / 24, jt = tile - tm * 24;
    const int job = jt >> 3, tn = jt & 7;
    GemmA ga; ga.mix = nullptr; ga.sh0 = nullptr; ga.zero = nullptr;
    const bf16_t* Bt; int K;
    if (job == 0) { ga.A = (const bf16_t*)(ws + OFF_L1W); ga.lda = 64; Bt = (const bf16_t*)(ws + WT_W2); K = 64; }
    else if (job == 1) { ga.A = (const bf16_t*)(ws + OFF_L1A); ga.lda = 64; Bt = (const bf16_t*)(ws + WT_A2); K = 64; }
    else { ga.A = (const bf16_t*)(ws + OFF_L1G); ga.lda = 192; Bt = (const bf16_t*)(ws + WT_G2); K = 192; }
    f32x16 acc[2][2];
    if (job == 1) {
      gemm_mainloop<0, 1>(acc, ga, Bt, K, 1024, K, tm * 128, tn * 128, sA, sB);
      const float* a0 = p.in[15];
      gemm_epilogue_bf16_lds(acc, (bf16_t*)(ws + OFF_A), DM, tm * 128, tn * 128, tn * 128, sA, [&](int col, float v) { return sigmoidf_(a0[col] + v); });
      continue;
    }
    if (job == 2) {
      gemm_mainloop<0, 1>(acc, ga, Bt, K, 1024, K, tm * 128, tn * 128, sA, sB);
      gemm_epilogue_bf16_lds(acc, (bf16_t*)(ws + OFF_G), DM, tm * 128, tn * 128, tn * 128, sA, [&](int, float v) { return v; });
      continue;
    }
    gemm_mainloop<0>(acc, ga, Bt, K, 1024, K, tm * 128, tn * 128, sA, sB);
    if (job == 0) {
      float* o = (float*)(ws + OFF_DEC); const float* w0 = p.in[12];
      gemm_epilogue(acc, tm * 128, tn * 128, [&](int row, int col, float v) {
        const float wl = -softplusf_(-(w0[col] + v)) - 0.5f;
        o[(size_t)row * DM + col] = -__expf(wl);
      });
    } else if (job == 1) {
      bf16_t* o = (bf16_t*)(ws + OFF_A); const float* a0 = p.in[15];
      gemm_epilogue(acc, tm * 128, tn * 128, [&](int row, int col, float v) { o[(size_t)row * DM + col] = f2bf(sigmoidf_(a0[col] + v)); });
    } else {
      bf16_t* o = (bf16_t*)(ws + OFF_G);
      gemm_epilogue(acc, tm * 128, tn * 128, [&](int row, int col, float v) { o[(size_t)row * DM + col] = f2bf(v); });
    }
  }
}

typedef float f32x4v __attribute__((ext_vector_type(4)));
struct RBlk { bf16_t* base; int stride; };
__device__ __forceinline__ RBlk rwkv_blk(char* ws, size_t arr_off, int which, bool prompt, size_t tok0, int h, int sidx) {
  RBlk r;
  if (prompt) {
    if (which == 4) { r.base = (bf16_t*)(ws + OFF_DEC) + tok0 * 2048 + h * 128; r.stride = 2048; }
    else { r.base = (bf16_t*)(ws + arr_off) + tok0 * DM + h * 64; r.stride = DM; }
  }
  else { r.base = (bf16_t*)(ws + OFF_RSP) + ((size_t)sidx * 5 + which) * 1024; r.stride = 64; }
  return r;
}
__device__ __forceinline__ void phase_rwkv_prep(const Params& p, char* smem) {
  const int lane = threadIdx.x & 63, wave = threadIdx.x >> 6;
  char* ws = p.ws;
  char* wsm = smem + wave * 17856;
  bf16_t* sQR = (bf16_t*)wsm;
  bf16_t* sBK = sQR + 32 * 72;
  float* sC = (float*)(sBK + 32 * 72);
  bf16_t* sV = (bf16_t*)(sC + 32 * 33);
  float* sX = (float*)(sV + 16 * 72);
  const bf16_t* Rb = (const bf16_t*)(ws + OFF_R); const bf16_t* Kb = (const bf16_t*)(ws + OFF_K);
  const bf16_t* Vb = (const bf16_t*)(ws + OFF_V); const bf16_t* Ab = (const bf16_t*)(ws + OFF_A);
  const float* LWb = (const float*)(ws + OFF_DEC);
  float* BON = (float*)(ws + OFF_BON);
  const int c16 = lane & 15, g = lane >> 4;
  for (int it = blockIdx.x * 4 + wave; it < 18560; it += gridDim.x * 4) {
    const bool prompt = it < 16512;
    int h, nvalid, sidx = 0; size_t tok0;
    if (prompt) { h = it & 15; const int q = it >> 4; const int b = q / 129, ch = q - b * 129; tok0 = (size_t)b * LP + ch * 16; nvalid = 16; }
    else { sidx = it - 16512; h = sidx & 15; tok0 = TP + (size_t)(sidx >> 4) * 4; nvalid = 4; }
    const int col = h * 64 + lane;
    const float kkc = p.in[20][col], kac = p.in[21][col], rkc = p.in[22][col];
    float rr[16], kr[16], vr[16], ar[16], lw[16];
#pragma unroll
    for (int tt = 0; tt < 16; tt++) {
      if (tt < nvalid) {
        const size_t off = (tok0 + tt) * DM + col;
        rr[tt] = bf2f(Rb[off]); kr[tt] = bf2f(Kb[off]); vr[tt] = bf2f(Vb[off]); ar[tt] = bf2f(Ab[off]); lw[tt] = LWb[off];
      } else { rr[tt] = 0.f; kr[tt] = 0.f; vr[tt] = 0.f; ar[tt] = 0.f; lw[tt] = 0.f; }
    }
    float bi[16], ki[16];
    float cum = 0.f;
#pragma unroll
    for (int tt = 0; tt < 16; tt++) {
      float kk = kr[tt] * kkc;
      const float n2 = wave_sum(kk * kk);
      kk = kk / fmaxf(sqrtf(n2), 1e-12f);
      const float kp = kr[tt] * (1.f + (ar[tt] - 1.f) * kac);
      const float bb = kk * ar[tt];
      const float bon = wave_sum(rr[tt] * kp * rkc);
      if (tt < nvalid && lane == 0) BON[(tok0 + tt) * 16 + h] = bon;
      const float eprev = __expf(cum);
      cum += lw[tt];
      const float ecur = __expf(cum), einv = __expf(-cum);
      bi[tt] = bb * einv; ki[tt] = kp * einv;
      sQR[tt * 72 + lane] = f2bf(kk * eprev);
      sQR[(16 + tt) * 72 + lane] = f2bf(rr[tt] * ecur);
      sBK[tt * 72 + lane] = f2bf(bi[tt]);
      sBK[(16 + tt) * 72 + lane] = f2bf(ki[tt]);
      sV[tt * 72 + lane] = f2bf(vr[tt]);
    }
    const float eQ = __expf(cum);
    char* small = ws + OFF_RSM + (size_t)it * RSM_ITEM;
    ((float*)(small + 2048))[lane] = eQ;
    asm volatile("s_waitcnt lgkmcnt(0)" ::: "memory");
    __builtin_amdgcn_wave_barrier();
    {
      f32x16 acc;
#pragma unroll
      for (int r = 0; r < 16; r++) acc[r] = 0.f;
#pragma unroll
      for (int ks = 0; ks < 4; ks++) {
        const bf16x8 af = *(const bf16x8*)(sQR + (lane & 31) * 72 + ks * 16 + (lane >> 5) * 8);
        const bf16x8 bf = *(const bf16x8*)(sBK + (lane & 31) * 72 + ks * 16 + (lane >> 5) * 8);
        acc = __builtin_amdgcn_mfma_f32_32x32x16_bf16(af, bf, acc, 0, 0, 0);
      }
#pragma unroll
      for (int r = 0; r < 16; r++) sC[((lane >> 5) * 4 + (r & 3) + 8 * (r >> 2)) * 33 + (lane & 31)] = acc[r];
    }
    asm volatile("s_waitcnt lgkmcnt(0)" ::: "memory");
    __builtin_amdgcn_wave_barrier();
#pragma unroll
    for (int tt = 0; tt < 16; tt++) {
      sBK[tt * 72 + lane] = f2bf(bi[tt] * eQ);
      sBK[(16 + tt) * 72 + lane] = f2bf(ki[tt] * eQ);
    }
    {
      const int c = lane & 31;
      float xr[16];
#pragma unroll
      for (int t = 0; t < 16; t++) {
        float acc;
        if (c < 16) acc = (c == t) ? 1.f : 0.f;
        else acc = ((c - 16) < t) ? sC[t * 33 + c] : 0.f;
#pragma unroll
        for (int i = 0; i < 16; i++) if (i < t) acc -= sC[t * 33 + i] * xr[i];
        xr[t] = acc;
      }
      if (lane < 32) {
#pragma unroll
        for (int t = 0; t < 16; t++) sX[t * 33 + c] = -xr[t];
      }
    }
    asm volatile("s_waitcnt lgkmcnt(0)" ::: "memory");
    __builtin_amdgcn_wave_barrier();
    {
      float f[8];
#pragma unroll
      for (int jj = 0; jj < 4; jj++) { f[jj] = sX[c16 * 33 + 4 * g + jj]; f[4 + jj] = sX[c16 * 33 + 16 + 4 * g + jj]; }
      ((uint4*)small)[lane] = pack8(f);
#pragma unroll
      for (int jj = 0; jj < 4; jj++) {
        const int i = 4 * g + jj;
        f[jj] = (i <= c16) ? sC[(16 + c16) * 33 + i] : 0.f;
        f[4 + jj] = (i <= c16) ? sC[(16 + c16) * 33 + 16 + i] : 0.f;
      }
      ((uint4*)(small + 1024))[lane] = pack8(f);
    }
    {
      const RBlk bq = rwkv_blk(ws, OFF_R, 0, prompt, tok0, h, sidx), br = rwkv_blk(ws, OFF_K, 1, prompt, tok0, h, sidx);
#pragma unroll
      for (int m = 0; m < 2; m++) {
        const int idx = m * 64 + lane;
        const int k0 = 32 * m + 4 * g;
        const uint2 q0 = *(const uint2*)(sQR + c16 * 72 + k0), q1 = *(const uint2*)(sQR + c16 * 72 + k0 + 16);
        *(uint4*)(bq.base + (size_t)(idx >> 3) * bq.stride + (idx & 7) * 8) = make_uint4(q0.x, q0.y, q1.x, q1.y);
        const uint2 r0 = *(const uint2*)(sQR + (16 + c16) * 72 + k0), r1 = *(const uint2*)(sQR + (16 + c16) * 72 + k0 + 16);
        *(uint4*)(br.base + (size_t)(idx >> 3) * br.stride + (idx & 7) * 8) = make_uint4(r0.x, r0.y, r1.x, r1.y);
      }
    }
    {
      const RBlk b0 = rwkv_blk(ws, OFF_A, 2, prompt, tok0, h, sidx), b1 = rwkv_blk(ws, OFF_BB, 3, prompt, tok0, h, sidx);
#pragma unroll
      for (int kb = 0; kb < 4; kb++) {
        const int k = 16 * kb + c16;
        unsigned w[4];
#pragma unroll
        for (int e = 0; e < 2; e++) {
          w[e] = (unsigned)sBK[(4 * g + 2 * e) * 72 + k] | ((unsigned)sBK[(4 * g + 2 * e + 1) * 72 + k] << 16);
          w[2 + e] = (unsigned)sBK[(16 + 4 * g + 2 * e) * 72 + k] | ((unsigned)sBK[(16 + 4 * g + 2 * e + 1) * 72 + k] << 16);
        }
        const RBlk& bk = (kb < 2) ? b0 : b1;
        const int idx = (kb & 1) * 64 + lane;
        *(uint4*)(bk.base + (size_t)(idx >> 3) * bk.stride + (idx & 7) * 8) = make_uint4(w[0], w[1], w[2], w[3]);
      }
    }
    {
      const RBlk bv = rwkv_blk(ws, OFF_V, 4, prompt, tok0, h, sidx);
#pragma unroll
      for (int vq = 0; vq < 4; vq++) {
        const int v = vq * 16 + c16;
        const unsigned w0 = (unsigned)sV[(4 * g) * 72 + v] | ((unsigned)sV[(4 * g + 1) * 72 + v] << 16);
        const unsigned w1 = (unsigned)sV[(4 * g + 2) * 72 + v] | ((unsigned)sV[(4 * g + 3) * 72 + v] << 16);
        const int idx = vq * 64 + lane;
        *(uint2*)(bv.base + (size_t)(idx >> 4) * bv.stride + (idx & 15) * 4) = make_uint2(w0, w1);
      }
    }
    asm volatile("s_waitcnt lgkmcnt(0)" ::: "memory");
    __builtin_amdgcn_wave_barrier();
  }
}

struct RPf { uint4 a, b, c, d; };
__device__ __forceinline__ bf16x8 pk8(float a0, float a1, float a2, float a3, unsigned w2, unsigned w3) {
  return __builtin_bit_cast(bf16x8, make_uint4(cvtpk(a0, a1), cvtpk(a2, a3), w2, w3));
}
__device__ __forceinline__ void rwkv_scan_block(const Params& p, int hitem, char* smem) {
  const int tid = threadIdx.x, lane = tid & 63, vq = tid >> 6;
  const int c16 = lane & 15, g = lane >> 4;
  char* ws = p.ws;
  const bool prompt = hitem < 128;
  int h, nch, nvalid, sidx = 0, b; size_t tokb; const float* S0; float* Sout;
  if (prompt) { b = hitem >> 4; h = hitem & 15; nch = 129; nvalid = 16; tokb = (size_t)b * LP; S0 = nullptr; Sout = p.out + OUT3 + (size_t)hitem * 4096; }
  else { sidx = hitem - 128; b = sidx >> 4; h = sidx & 15; nch = 1; nvalid = 4; tokb = TP + (size_t)b * 4; S0 = p.in[3] + (size_t)sidx * 4096; Sout = p.out + OUT7 + (size_t)sidx * 4096; }
  f32x4v st[4];
#pragma unroll
  for (int kb = 0; kb < 4; kb++) {
    if (S0) { const float4 v = *(const float4*)(S0 + (vq * 16 + c16) * 64 + 16 * kb + 4 * g); st[kb] = f32x4v{v.x, v.y, v.z, v.w}; }
    else st[kb] = f32x4v{0.f, 0.f, 0.f, 0.f};
  }
  bf16_t* Ob = (bf16_t*)(ws + OFF_Y);
  const char *pa, *pb, *pc, *pd; size_t sta, stc, stv;
  {
    const size_t tok0 = tokb;
    const int it0 = prompt ? ((b * 129) * 16 + h) : (16512 + sidx);
    const int idx = tid & 127;
    const RBlk Ba = (tid < 128) ? rwkv_blk(ws, OFF_R, 0, prompt, tok0, h, sidx) : rwkv_blk(ws, OFF_K, 1, prompt, tok0, h, sidx);
    pa = (const char*)(Ba.base + (size_t)(idx >> 3) * Ba.stride + (idx & 7) * 8);
    const RBlk Bb = (tid < 128) ? rwkv_blk(ws, OFF_A, 2, prompt, tok0, h, sidx) : rwkv_blk(ws, OFF_BB, 3, prompt, tok0, h, sidx);
    pb = (const char*)(Bb.base + (size_t)(idx >> 3) * Bb.stride + (idx & 7) * 8);
    const char* small = ws + OFF_RSM + (size_t)it0 * RSM_ITEM;
    if (tid < 128) pc = small + tid * 16;
    else {
      const RBlk Bv = rwkv_blk(ws, OFF_V, 4, prompt, tok0, h, sidx);
      const int i2 = 2 * (tid - 128);
      pc = (const char*)(Bv.base + (size_t)(i2 >> 4) * Bv.stride + (i2 & 15) * 4);
    }
    pd = small + 2048 + (tid & 15) * 16;
    sta = (size_t)16 * DM * 2;
    stc = (size_t)16 * RSM_ITEM;
    stv = (tid < 128) ? stc : (size_t)16 * 2048 * 2;
  }
  auto issue = [&](uint4& fa, uint4& fb, uint4& fc, uint4& fd, int ch) __attribute__((always_inline)) {
    fa = *(const uint4*)(pa + (size_t)ch * sta);
    fb = *(const uint4*)(pb + (size_t)ch * sta);
    fc = *(const uint4*)(pc + (size_t)ch * stv);
    fd = *(const uint4*)(pd + (size_t)ch * stc);
  };
  auto body = [&](uint4& fa, uint4& fb, uint4& fc, uint4& fd, int ch) __attribute__((always_inline)) {
    uint4* slot = (uint4*)(smem + (ch & 1) * 12544);
    slot[tid] = fa; slot[256 + tid] = fb; slot[512 + tid] = fc;
    if (tid < 16) slot[768 + tid] = fd;
    if (ch + 8 < nch) issue(fa, fb, fc, fd, ch + 8);
    __syncthreads();
    const uint4 kq0 = slot[lane], kq1 = slot[64 + lane], rq0 = slot[128 + lane], rq1 = slot[192 + lane];
    const uint4 se0 = slot[256 + lane], se1 = slot[320 + lane], se2 = slot[384 + lane], se3 = slot[448 + lane];
    const uint4 tu = slot[512 + lane], ao = slot[576 + lane];
    const uint2 vb = ((const uint2*)(slot + 640))[vq * 64 + lane];
    const float4* pqp = (const float4*)(slot + 768);
    const f32x4v z4 = f32x4v{0.f, 0.f, 0.f, 0.f};
    const bf16x8 bs0 = __builtin_bit_cast(bf16x8, make_uint4(cvtpk(st[0][0], st[0][1]), cvtpk(st[0][2], st[0][3]), cvtpk(st[1][0], st[1][1]), cvtpk(st[1][2], st[1][3])));
    const bf16x8 bs1 = __builtin_bit_cast(bf16x8, make_uint4(cvtpk(st[2][0], st[2][1]), cvtpk(st[2][2], st[2][3]), cvtpk(st[3][0], st[3][1]), cvtpk(st[3][2], st[3][3])));
    f32x4v w1 = __builtin_amdgcn_mfma_f32_16x16x32_bf16(__builtin_bit_cast(bf16x8, kq0), bs0, z4, 0, 0, 0);
    w1 = __builtin_amdgcn_mfma_f32_16x16x32_bf16(__builtin_bit_cast(bf16x8, kq1), bs1, w1, 0, 0, 0);
    f32x4v w3 = __builtin_amdgcn_mfma_f32_16x16x32_bf16(__builtin_bit_cast(bf16x8, rq0), bs0, z4, 0, 0, 0);
    w3 = __builtin_amdgcn_mfma_f32_16x16x32_bf16(__builtin_bit_cast(bf16x8, rq1), bs1, w3, 0, 0, 0);
    const bf16x8 bu = pk8(w1[0], w1[1], w1[2], w1[3], vb.x, vb.y);
    const f32x4v u = __builtin_amdgcn_mfma_f32_16x16x32_bf16(__builtin_bit_cast(bf16x8, tu), bu, z4, 0, 0, 0);
    const bf16x8 bo = pk8(u[0], u[1], u[2], u[3], vb.x, vb.y);
    const f32x4v o = __builtin_amdgcn_mfma_f32_16x16x32_bf16(__builtin_bit_cast(bf16x8, ao), bo, w3, 0, 0, 0);
    {
      const float4 q0 = pqp[g], q1 = pqp[4 + g], q2 = pqp[8 + g], q3 = pqp[12 + g];
      st[0] = __builtin_amdgcn_mfma_f32_16x16x32_bf16(__builtin_bit_cast(bf16x8, se0), bo, st[0] * f32x4v{q0.x, q0.y, q0.z, q0.w}, 0, 0, 0);
      st[1] = __builtin_amdgcn_mfma_f32_16x16x32_bf16(__builtin_bit_cast(bf16x8, se1), bo, st[1] * f32x4v{q1.x, q1.y, q1.z, q1.w}, 0, 0, 0);
      st[2] = __builtin_amdgcn_mfma_f32_16x16x32_bf16(__builtin_bit_cast(bf16x8, se2), bo, st[2] * f32x4v{q2.x, q2.y, q2.z, q2.w}, 0, 0, 0);
      st[3] = __builtin_amdgcn_mfma_f32_16x16x32_bf16(__builtin_bit_cast(bf16x8, se3), bo, st[3] * f32x4v{q3.x, q3.y, q3.z, q3.w}, 0, 0, 0);
    }
#pragma unroll
    for (int j = 0; j < 4; j++) {
      const int t = 4 * g + j;
      if (t < nvalid) Ob[(tokb + (size_t)ch * 16 + t) * DM + h * 64 + vq * 16 + c16] = f2bf(o[j]);
    }
  };
  uint4 a0, b0, c0, d0, a1, b1, c1, d1, a2, b2, c2, d2, a3, b3, c3, d3, a4, b4, c4, d4, a5, b5, c5, d5, a6, b6, c6, d6, a7, b7, c7, d7;
  issue(a0, b0, c0, d0, 0);
  if (1 < nch) issue(a1, b1, c1, d1, 1);
  if (2 < nch) issue(a2, b2, c2, d2, 2);
  if (3 < nch) issue(a3, b3, c3, d3, 3);
  if (4 < nch) issue(a4, b4, c4, d4, 4);
  if (5 < nch) issue(a5, b5, c5, d5, 5);
  if (6 < nch) issue(a6, b6, c6, d6, 6);
  if (7 < nch) issue(a7, b7, c7, d7, 7);
  for (int cc = 0; cc < nch; cc += 8) {
    body(a0, b0, c0, d0, cc);
    if (cc + 1 < nch) body(a1, b1, c1, d1, cc + 1);
    if (cc + 2 < nch) body(a2, b2, c2, d2, cc + 2);
    if (cc + 3 < nch) body(a3, b3, c3, d3, cc + 3);
    if (cc + 4 < nch) body(a4, b4, c4, d4, cc + 4);
    if (cc + 5 < nch) body(a5, b5, c5, d5, cc + 5);
    if (cc + 6 < nch) body(a6, b6, c6, d6, cc + 6);
    if (cc + 7 < nch) body(a7, b7, c7, d7, cc + 7);
  }
#pragma unroll
  for (int kb = 0; kb < 4; kb++)
    *(float4*)(Sout + (vq * 16 + c16) * 64 + 16 * kb + 4 * g) = make_float4(st[kb][0], st[kb][1], st[kb][2], st[kb][3]);
  __syncthreads();
}

__device__ __forceinline__ void late_transposes(const Params& p, char* smem, int vb, int vnb) {
  float* tile = (float*)smem;
  char* ws = p.ws;
  __syncthreads();
  transpose_job(p.in[25], 1024, 1024, (bf16_t*)(ws + WT_WO), 1024, 1024, tile, 175, vb, vnb);
  transpose_job(p.in[34], 1024, 2048, (bf16_t*)(ws + WT_Q), 1024, 2048, tile, 128, vb, vnb);
  convert_linear(p.in[35], (bf16_t*)(ws + WT_SK), 65536, false, vb, vnb);
  transpose_job(p.in[26], 1024, 5152, (bf16_t*)(ws + WT_IN), 1024, 5152, tile, 0, vb, vnb);
  transpose_job(p.in[33], 2048, 1024, (bf16_t*)(ws + WT_OUT), 2048, 1024, tile, 64, vb, vnb);
  transpose_job(p.in[34] + 2097152, 1024, 2048, (bf16_t*)(ws + WT_Q) + 2097152, 1024, 2048, tile, 192, vb, vnb);
}

__device__ __forceinline__ void phase_rwkv_scan(const Params& p, char* smem) {
  const int nb = gridDim.x, bid = blockIdx.x;
  if (nb > 192) {
    if (bid < 128) rwkv_scan_block(p, bid, smem);
    else {
      for (int it = bid - 128; it < 2048; it += nb - 128) rwkv_scan_block(p, 128 + it, smem);
      convert_tables_fp8(p, bid - 128, nb - 128, 0);
      late_transposes(p, smem, bid - 128, nb - 128);
    }
  } else {
    for (int it = bid; it < 128 + 2048; it += nb) rwkv_scan_block(p, it, smem);
    convert_tables_fp8(p, bid, nb, 0);
    late_transposes(p, smem, bid, nb);
  }
}

__device__ __forceinline__ void phase_rwkv_out(const Params& p) {
  const int lane = threadIdx.x & 63, wave = threadIdx.x >> 6;
  char* ws = p.ws;
  bf16_t* Yb = (bf16_t*)(ws + OFF_Y);
  const bf16_t* Vb = (const bf16_t*)(ws + OFF_V); const bf16_t* Gb = (const bf16_t*)(ws + OFF_G);
  const float* BON = (const float*)(ws + OFF_BON);
  for (int it = blockIdx.x * 4 + wave; it < TT * 2; it += gridDim.x * 4) {
    const int col = (it & 1) * 512 + lane * 8;
    const size_t off = (size_t)(it >> 1) * DM + col;
    float o[8], v[8], g[8], y[8];
    unpack8(*(const uint4*)(Yb + off), o); unpack8(*(const uint4*)(Vb + off), v); unpack8(*(const uint4*)(Gb + off), g);
    const float bon = BON[(size_t)(it >> 1) * 16 + (it & 1) * 8 + (lane >> 3)];
    const float4 w0 = *(const float4*)(p.in[23] + col), w1 = *(const float4*)(p.in[23] + col + 4);
    const float4 b0 = *(const float4*)(p.in[24] + col), b1 = *(const float4*)(p.in[24] + col + 4);
    const float lw[8] = {w0.x, w0.y, w0.z, w0.w, w1.x, w1.y, w1.z, w1.w};
    const float lb[8] = {b0.x, b0.y, b0.z, b0.w, b1.x, b1.y, b1.z, b1.w};
    float sm = 0.f;
#pragma unroll
    for (int e = 0; e < 8; e++) sm += o[e];
    const float mu = oct_sum(sm) * (1.f / 64.f);
    float sv = 0.f;
#pragma unroll
    for (int e = 0; e < 8; e++) { o[e] -= mu; sv += o[e] * o[e]; }
    const float rs = rsqrtf(oct_sum(sv) * (1.f / 64.f) + 64e-5f);
#pragma unroll
    for (int e = 0; e < 8; e++) y[e] = (o[e] * rs * lw[e] + lb[e] + bon * v[e]) * g[e];
    *(uint4*)(Yb + off) = pack8(y);
  }
}

__device__ __forceinline__ void phase_gemm_hadd(const Params& p, char* smem, const bf16_t* A, int lda, const bf16_t* Bt, int K, bool dry = false) {
  bf16_t* sA = (bf16_t*)smem; bf16_t* sB = sA + 128 * SAS;
  float* H = (float*)(p.ws + OFF_H);
  for (int tile = blockIdx.x; tile < 133 * 8; tile += gridDim.x) {
    const int tm = tile >> 3, tn = tile & 7;
    GemmA ga; ga.A = A; ga.lda = lda; ga.mix = nullptr; ga.sh0 = nullptr; ga.zero = nullptr;
    f32x16 acc[2][2];
    gemm_mainloop<0>(acc, ga, Bt, K, 1024, K, tm * 128, tn * 128, sA, sB);
    gemm_epilogue(acc, tm * 128, tn * 128, [&](int row, int col, float v) { if (!dry || v == 1.2345e30f) H[(size_t)row * DM + col] += v; });
  }
}

__device__ __forceinline__ void phase_peer_norm(const Params& p, int layer) {
  const int tid = threadIdx.x, lane = tid & 63, wave = tid >> 6;
  const float* H = (const float*)(p.ws + OFF_H);
  bf16_t* XN2 = (bf16_t*)(p.ws + (layer ? OFF_XN2_1 : OFF_XN2_0));
  const float4* g = (const float4*)(p.in[8] + layer * DM);
  for (int t = blockIdx.x * 4 + wave; t < TT; t += gridDim.x * 4) {
    float4 v[4]; float ss = 0.f;
#pragma unroll
    for (int i = 0; i < 4; i++) {
      v[i] = ((const float4*)(H + (size_t)t * DM))[i * 64 + lane];
      ss += v[i].x * v[i].x + v[i].y * v[i].y + v[i].z * v[i].z + v[i].w * v[i].w;
    }
    ss = wave_sum(ss);
    const float rstd = rsqrtf(ss * (1.f / 1024.f) + 1e-5f);
#pragma unroll
    for (int i = 0; i < 4; i++) {
      const float4 gg = g[i * 64 + lane];
      ((uint2*)(XN2 + (size_t)t * DM))[i * 64 + lane] =
          make_uint2(cvtpk(v[i].x * rstd * gg.x, v[i].y * rstd * gg.y), cvtpk(v[i].z * rstd * gg.z, v[i].w * rstd * gg.w));
    }
  }
}

__device__ __forceinline__ void phase_peer_query(const Params& p, int layer, char* smem) {
  const int tid = threadIdx.x, lane = tid & 63, wave = tid >> 6;
  const int wm = wave >> 1, wn = wave & 1;
  bf16_t* sA = (bf16_t*)smem; bf16_t* sB = sA + 128 * SAS;
  bf16_t* Qs = (bf16_t*)smem; bf16_t* Ks = Qs + 128 * 136;
  float* Ss = (float*)smem;
  char* ws = p.ws;
  const bf16_t* XN2 = (const bf16_t*)(ws + (layer ? OFF_XN2_1 : OFF_XN2_0));
  int* KEYS = (int*)(ws + (layer ? OFF_KEYS_1 : OFF_KEYS_0));
  const bf16_t* Bt = (const bf16_t*)(ws + WT_Q) + (size_t)layer * 2097152;
  for (int tile = blockIdx.x; tile < 133 * 16; tile += gridDim.x) {
    const int tm = tile >> 4, tn = tile & 15;
    GemmA ga; ga.A = XN2; ga.lda = DM; ga.mix = nullptr; ga.sh0 = nullptr; ga.zero = nullptr;
    f32x16 acc[2][2];
    gemm_mainloop<0>(acc, ga, Bt, 1024, 2048, 1024, tm * 128, tn * 128, sA, sB);
    __syncthreads();
#pragma unroll
    for (int i = 0; i < 2; i++)
#pragma unroll
      for (int j = 0; j < 2; j++)
#pragma unroll
        for (int r = 0; r < 16; r++) {
          const int rowl = wm * 64 + i * 32 + (lane >> 5) * 4 + (r & 3) + 8 * (r >> 2);
          const int coll = wn * 64 + j * 32 + (lane & 31);
          Qs[rowl * 136 + coll] = f2bf(acc[i][j][r]);
        }
    {
      const int hh = tn >> 1, z = tn & 1;
      const bf16_t* kp = (const bf16_t*)(ws + WT_SK) + ((size_t)((layer * 2 + z) * 8 + hh)) * 16384;
#pragma unroll
      for (int c = tid; c < 2048; c += 256) {
        const int key = c >> 4, dc = c & 15;
        *(uint4*)(Ks + key * 136 + dc * 8) = *(const uint4*)(kp + key * 128 + dc * 8);
      }
    }
    __syncthreads();
#pragma unroll
    for (int i = 0; i < 2; i++)
#pragma unroll
      for (int j = 0; j < 2; j++)
#pragma unroll
        for (int r = 0; r < 16; r++) acc[i][j][r] = 0.f;
#pragma unroll
    for (int ks = 0; ks < 8; ks++) {
      bf16x8 a[2], b[2];
#pragma unroll
      for (int i = 0; i < 2; i++) {
        a[i] = *(const bf16x8*)(Qs + (wm * 64 + i * 32 + (lane & 31)) * 136 + ks * 16 + (lane >> 5) * 8);
        b[i] = *(const bf16x8*)(Ks + (wn * 64 + i * 32 + (lane & 31)) * 136 + ks * 16 + (lane >> 5) * 8);
      }
#pragma unroll
      for (int i = 0; i < 2; i++)
#pragma unroll
        for (int j = 0; j < 2; j++) acc[i][j] = __builtin_amdgcn_mfma_f32_32x32x16_bf16(a[i], b[j], acc[i][j], 0, 0, 0);
    }
    __syncthreads();
#pragma unroll
    for (int i = 0; i < 2; i++)
#pragma unroll
      for (int j = 0; j < 2; j++)
#pragma unroll
        for (int r = 0; r < 16; r++) {
          const int rowl = wm * 64 + i * 32 + (lane >> 5) * 4 + (r & 3) + 8 * (r >> 2);
          const int coll = wn * 64 + j * 32 + (lane & 31);
          Ss[rowl * 136 + coll + wn * 4] = acc[i][j][r];
        }
    __syncthreads();
    {
      const int row = tid >> 1, half = tid & 1;
      int L[16];
#pragma unroll
      for (int j = 0; j < 16; j++) L[j] = (int)0x80000000;
      const float4* sp = (const float4*)(Ss + row * 136 + half * 68);
#pragma unroll 1
      for (int blk = 0; blk < 4; blk++) {
        int bk[16];
#pragma unroll
        for (int c4 = 0; c4 < 4; c4++) {
          const float4 v = sp[blk * 4 + c4];
          const int cb = half * 64 + blk * 16 + c4 * 4;
          bk[c4 * 4 + 0] = (enc_key(v.x) & ~0x7F) | (cb + 0);
          bk[c4 * 4 + 1] = (enc_key(v.y) & ~0x7F) | (cb + 1);
          bk[c4 * 4 + 2] = (enc_key(v.z) & ~0x7F) | (cb + 2);
          bk[c4 * 4 + 3] = (enc_key(v.w) & ~0x7F) | (cb + 3);
        }
        sort16_desc(bk);
        merge16_desc(L, bk);
      }
      int m[16];
#pragma unroll
      for (int j = 0; j < 16; j++) m[j] = dpp_i<0xB1>(L[15 - j]);
#pragma unroll
      for (int j = 0; j < 16; j++) m[j] = max(m[j], L[j]);
#define BSTAGE(d_)                                                                                          \
  _Pragma("unroll") for (int j = 0; j < 16; j++) if ((j & (d_)) == 0) {                                    \
    const int hi = max(m[j], m[j + (d_)]), lo = min(m[j], m[j + (d_)]); m[j] = hi; m[j + (d_)] = lo; }
      BSTAGE(8) BSTAGE(4) BSTAGE(2) BSTAGE(1)
      int4* dst = (int4*)(KEYS + ((size_t)(tm * 128 + row) * 16 + tn) * 16);
      if (half == 0) {
        dst[0] = make_int4(m[0], m[1], m[2], m[3]);
        dst[1] = make_int4(m[4], m[5], m[6], m[7]);
      } else {
        dst[2] = make_int4(m[8], m[9], m[10], m[11]);
        dst[3] = make_int4(m[12], m[13], m[14], m[15]);
      }
    }
  }
}

__device__ __forceinline__ float gelu_exact(float x) { return 0.5f * x * (1.f + erff(x * 0.70710678118654752f)); }

__device__ __forceinline__ void phase_peer_route(const Params& p, int layer) {
  char* ws = p.ws;
  const int* KEYS = (const int*)(ws + (layer ? OFF_KEYS_1 : OFF_KEYS_0));
  int* EG = (int*)(ws + (layer ? OFF_KEYS_1 : OFF_KEYS_0) + 17432576);
  for (int it = blockIdx.x * 256 + threadIdx.x; it < TT * 8; it += gridDim.x * 256) {
    const int t = it >> 3, head = it & 7;
    const int* kz0 = KEYS + ((size_t)t * 16 + head * 2) * 16;
    const int* kz1 = kz0 + 16;
    int ka[16], kb[16];
#pragma unroll
    for (int j4 = 0; j4 < 4; j4++) {
      int4 x = ((const int4*)kz0)[j4]; ka[j4 * 4] = x.x; ka[j4 * 4 + 1] = x.y; ka[j4 * 4 + 2] = x.z; ka[j4 * 4 + 3] = x.w;
      int4 y = ((const int4*)kz1)[j4]; kb[j4 * 4] = y.x; kb[j4 * 4 + 1] = y.y; kb[j4 * 4 + 2] = y.z; kb[j4 * 4 + 3] = y.w;
    }
    float af[16], bf_[16];
#pragma unroll
    for (int j = 0; j < 16; j++) { af[j] = dec_key(ka[j] & ~0x7F); bf_[j] = dec_key(kb[j] & ~0x7F); }
    int L[16];
#pragma unroll
    for (int j = 0; j < 16; j++) L[j] = (int)0x80000000;
    {
      int bk[16];
      bk[0] = (enc_key(af[0] + bf_[0]) & ~0xFF) | (0);
      bk[1] = (enc_key(af[0] + bf_[1]) & ~0xFF) | (1);
      bk[2] = (enc_key(af[0] + bf_[2]) & ~0xFF) | (2);
      bk[3] = (enc_key(af[0] + bf_[3]) & ~0xFF) | (3);
      bk[4] = (enc_key(af[0] + bf_[4]) & ~0xFF) | (4);
      bk[5] = (enc_key(af[0] + bf_[5]) & ~0xFF) | (5);
      bk[6] = (enc_key(af[0] + bf_[6]) & ~0xFF) | (6);
      bk[7] = (enc_key(af[0] + bf_[7]) & ~0xFF) | (7);
      bk[8] = (enc_key(af[0] + bf_[8]) & ~0xFF) | (8);
      bk[9] = (enc_key(af[0] + bf_[9]) & ~0xFF) | (9);
      bk[10] = (enc_key(af[0] + bf_[10]) & ~0xFF) | (10);
      bk[11] = (enc_key(af[0] + bf_[11]) & ~0xFF) | (11);
      bk[12] = (enc_key(af[0] + bf_[12]) & ~0xFF) | (12);
      bk[13] = (enc_key(af[0] + bf_[13]) & ~0xFF) | (13);
      bk[14] = (enc_key(af[0] + bf_[14]) & ~0xFF) | (14);
      bk[15] = (enc_key(af[0] + bf_[15]) & ~0xFF) | (15);
      sort16_desc(bk); merge16_desc(L, bk);
      bk[0] = (enc_key(af[1] + bf_[0]) & ~0xFF) | (16);
      bk[1] = (enc_key(af[1] + bf_[1]) & ~0xFF) | (17);
      bk[2] = (enc_key(af[1] + bf_[2]) & ~0xFF) | (18);
      bk[3] = (enc_key(af[1] + bf_[3]) & ~0xFF) | (19);
      bk[4] = (enc_key(af[1] + bf_[4]) & ~0xFF) | (20);
      bk[5] = (enc_key(af[1] + bf_[5]) & ~0xFF) | (21);
      bk[6] = (enc_key(af[1] + bf_[6]) & ~0xFF) | (22);
      bk[7] = (enc_key(af[1] + bf_[7]) & ~0xFF) | (23);
      bk[8] = (enc_key(af[2] + bf_[0]) & ~0xFF) | (32);
      bk[9] = (enc_key(af[2] + bf_[1]) & ~0xFF) | (33);
      bk[10] = (enc_key(af[2] + bf_[2]) & ~0xFF) | (34);
      bk[11] = (enc_key(af[2] + bf_[3]) & ~0xFF) | (35);
      bk[12] = (enc_key(af[2] + bf_[4]) & ~0xFF) | (36);
      bk[13] = (enc_key(af[3] + bf_[0]) & ~0xFF) | (48);
      bk[14] = (enc_key(af[3] + bf_[1]) & ~0xFF) | (49);
      bk[15] = (enc_key(af[3] + bf_[2]) & ~0xFF) | (50);
      sort16_desc(bk); merge16_desc(L, bk);
      bk[0] = (enc_key(af[3] + bf_[3]) & ~0xFF) | (51);
      bk[1] = (enc_key(af[4] + bf_[0]) & ~0xFF) | (64);
      bk[2] = (enc_key(af[4] + bf_[1]) & ~0xFF) | (65);
      bk[3] = (enc_key(af[4] + bf_[2]) & ~0xFF) | (66);
      bk[4] = (enc_key(af[5] + bf_[0]) & ~0xFF) | (80);
      bk[5] = (enc_key(af[5] + bf_[1]) & ~0xFF) | (81);
      bk[6] = (enc_key(af[6] + bf_[0]) & ~0xFF) | (96);
      bk[7] = (enc_key(af[6] + bf_[1]) & ~0xFF) | (97);
      bk[8] = (enc_key(af[7] + bf_[0]) & ~0xFF) | (112);
      bk[9] = (enc_key(af[7] + bf_[1]) & ~0xFF) | (113);
      bk[10] = (enc_key(af[8] + bf_[0]) & ~0xFF) | (128);
      bk[11] = (enc_key(af[9] + bf_[0]) & ~0xFF) | (144);
      bk[12] = (enc_key(af[10] + bf_[0]) & ~0xFF) | (160);
      bk[13] = (enc_key(af[11] + bf_[0]) & ~0xFF) | (176);
      bk[14] = (enc_key(af[12] + bf_[0]) & ~0xFF) | (192);
      bk[15] = (enc_key(af[13] + bf_[0]) & ~0xFF) | (208);
      sort16_desc(bk); merge16_desc(L, bk);
      INS16(L, (enc_key(af[14] + bf_[0]) & ~0xFF) | (224));
      INS16(L, (enc_key(af[15] + bf_[0]) & ~0xFF) | (240));
    }
    float ev[16]; float esum = 0.f;
    const float smax = dec_key(L[0] & ~0xFF);
#pragma unroll
    for (int k = 0; k < 16; k++) { ev[k] = __expf(dec_key(L[k] & ~0xFF) - smax); esum += ev[k]; }
    const float inv = 1.f / esum;
    int* eo = EG + (size_t)t * 256 + head * 16;
    int ei[16];
#pragma unroll
    for (int k = 0; k < 16; k++) {
      const int ci = (L[k] >> 4) & 15, cj = L[k] & 15;
      ei[k] = (kz0[ci] & 127) * 128 + (kz1[cj] & 127);
    }
#pragma unroll
    for (int k4 = 0; k4 < 4; k4++) {
      ((int4*)eo)[k4] = make_int4(ei[k4 * 4], ei[k4 * 4 + 1], ei[k4 * 4 + 2], ei[k4 * 4 + 3]);
      ((float4*)(eo + 128))[k4] = make_float4(ev[k4 * 4] * inv, ev[k4 * 4 + 1] * inv, ev[k4 * 4 + 2] * inv, ev[k4 * 4 + 3] * inv);
    }
  }
}

__device__ __forceinline__ float rs16(float (&q)[16], int lane) {
  const bool b0 = lane & 1, b1 = lane & 2, b2 = lane & 4, b3 = lane & 8;
  float a[8];
#pragma unroll
  for (int i = 0; i < 8; i++) { const float keep = b0 ? q[i + 8] : q[i], send = b0 ? q[i] : q[i + 8]; a[i] = keep + dpp_f<0xB1>(send); }
  float c[4];
#pragma unroll
  for (int i = 0; i < 4; i++) { const float keep = b1 ? a[i + 4] : a[i], send = b1 ? a[i] : a[i + 4]; c[i] = keep + dpp_f<0x4E>(send); }
  float d[2];
#pragma unroll
  for (int i = 0; i < 2; i++) { const float keep = b2 ? c[i + 2] : c[i], send = b2 ? c[i] : c[i + 2]; d[i] = keep + dpp_f<0x1B>(dpp_f<0x141>(send)); }
  const float keep = b3 ? d[1] : d[0], send = b3 ? d[0] : d[1];
  float v = keep + dpp_f<0x141>(dpp_f<0x140>(send));
  v += __shfl_xor(v, 16);
  v += __shfl_xor(v, 32);
  return v;
}
__device__ __forceinline__ constexpr int bitrev4(int x) { return ((x & 1) << 3) | ((x & 2) << 1) | ((x & 4) >> 1) | ((x & 8) >> 3); }

__device__ __forceinline__ void phase_peer_expert(const Params& p, int layer, char* smem, bool dry = false) {
  const int tid = threadIdx.x, lane = tid & 63, wave = tid >> 6;
  char* ws = p.ws;
  float* H = (float*)(ws + OFF_H);
  const bf16_t* XN2 = (const bf16_t*)(ws + (layer ? OFF_XN2_1 : OFF_XN2_0));
  const int* EG = (const int*)(ws + (layer ? OFF_KEYS_1 : OFF_KEYS_0) + 17432576);
  const uint2* Ub = (const uint2*)(ws + OFF_TAB) + (size_t)(layer * 2) * 16384 * 64;
  const uint2* Vb = Ub + (size_t)16384 * 64;
  const float* SCu = (const float*)(ws + WT_SC) + (layer * 2) * 16384;
  const float* SCv = SCu + 16384;
  const float* gn = layer ? p.in[9] : (p.in[7] + DM);
  const int pslot = (lane & 48) + bitrev4(lane & 15);
  const int per_round = gridDim.x * 4;
  const int nfull = TT / per_round;
  const int tail0 = nfull * per_round;
  const int ntail = TT - tail0;
  const int my_tail = ((int)blockIdx.x < ntail) ? ((ntail - 1 - (int)blockIdx.x) / (int)gridDim.x + 1) : 0;
  float* part = (float*)smem;
  for (int it = 0; it < nfull + my_tail; it++) {
    const bool coop = it >= nfull;
    const int t = coop ? (tail0 + (int)blockIdx.x + (it - nfull) * (int)gridDim.x) : (it * per_round + (int)blockIdx.x * 4 + wave);
    const int eb0 = coop ? wave * 32 : 0, eb1 = coop ? eb0 + 32 : 128;
    const int* eg = EG + (size_t)t * 256;
    const int e_lin0 = eg[lane], e_lin1 = eg[64 + lane];
    const int e_lo = eg[pslot], e_hi = eg[64 + pslot];
    const float g_lo = __int_as_float(eg[128 + pslot]), g_hi = __int_as_float(eg[192 + pslot]);
    const float su_lo = SCu[e_lo], su_hi = SCu[e_hi], sv_lo = SCv[e_lo], sv_hi = SCv[e_hi];
    f32x2_t x2[8];
    {
      const uint4 xa = *(const uint4*)(XN2 + (size_t)t * DM + lane * 16);
      const uint4 xb = *(const uint4*)(XN2 + (size_t)t * DM + lane * 16 + 8);
      x2[0] = f32x2_t{bflo(xa.x), bfhi(xa.x)}; x2[1] = f32x2_t{bflo(xa.y), bfhi(xa.y)};
      x2[2] = f32x2_t{bflo(xa.z), bfhi(xa.z)}; x2[3] = f32x2_t{bflo(xa.w), bfhi(xa.w)};
      x2[4] = f32x2_t{bflo(xb.x), bfhi(xb.x)}; x2[5] = f32x2_t{bflo(xb.y), bfhi(xb.y)};
      x2[6] = f32x2_t{bflo(xb.z), bfhi(xb.z)}; x2[7] = f32x2_t{bflo(xb.w), bfhi(xb.w)};
    }
    float d0 = 0.f, d1 = 0.f;
    for (int eb = eb0; eb < eb1; eb += 32) {
      const int esel = (eb < 64) ? e_lin0 : e_lin1;
      uint2 ua[32];
#pragma unroll
      for (int j = 0; j < 32; j++) {
        const int row = __builtin_amdgcn_readlane(esel, (eb + j) & 63);
        ua[j] = (Ub + (size_t)row * 64)[lane];
      }
#pragma unroll
      for (int hb = 0; hb < 2; hb++) {
        float q[16];
#pragma unroll
        for (int j = 0; j < 16; j++) {
          const uint2 u = ua[hb * 16 + j];
          f32x2_t a2 = __builtin_amdgcn_cvt_scalef32_pk_f32_fp4(u.x, 1.0f, 0) * x2[0];
          a2 += __builtin_amdgcn_cvt_scalef32_pk_f32_fp4(u.x, 1.0f, 1) * x2[1];
          a2 += __builtin_amdgcn_cvt_scalef32_pk_f32_fp4(u.x, 1.0f, 2) * x2[2];
          a2 += __builtin_amdgcn_cvt_scalef32_pk_f32_fp4(u.x, 1.0f, 3) * x2[3];
          a2 += __builtin_amdgcn_cvt_scalef32_pk_f32_fp4(u.y, 1.0f, 0) * x2[4];
          a2 += __builtin_amdgcn_cvt_scalef32_pk_f32_fp4(u.y, 1.0f, 1) * x2[5];
          a2 += __builtin_amdgcn_cvt_scalef32_pk_f32_fp4(u.y, 1.0f, 2) * x2[6];
          a2 += __builtin_amdgcn_cvt_scalef32_pk_f32_fp4(u.y, 1.0f, 3) * x2[7];
          q[j] = a2.x + a2.y;
        }
        const float v = rs16(q, lane);
        const int bt = (eb >> 4) + hb;
        if ((lane >> 4) == (bt & 3)) { if (bt < 4) d0 = v; else d1 = v; }
      }
    }
    const float c0 = g_lo * gelu_exact(d0 * su_lo) * sv_lo;
    const float c1 = g_hi * gelu_exact(d1 * su_hi) * sv_hi;
    f32x2_t o2[8];
#pragma unroll
    for (int i = 0; i < 8; i++) o2[i] = f32x2_t{0.f, 0.f};
    for (int eb = eb0; eb < eb1; eb += 32) {
      const int esel = (eb < 64) ? e_lin0 : e_lin1;
      uint2 va[32];
#pragma unroll
      for (int j = 0; j < 32; j++) {
        const int row = __builtin_amdgcn_readlane(esel, (eb + j) & 63);
        va[j] = (Vb + (size_t)row * 64)[lane];
      }
      const float csel = (eb < 64) ? c0 : c1;
      const int rbase = ((eb >> 4) & 3) * 16;
#pragma unroll
      for (int j = 0; j < 32; j++) {
        const float c = rdlane(csel, rbase + (j >> 4) * 16 + bitrev4(j & 15));
        const f32x2_t cc = f32x2_t{c, c};
        o2[0] += cc * __builtin_amdgcn_cvt_scalef32_pk_f32_fp4(va[j].x, 1.0f, 0);
        o2[1] += cc * __builtin_amdgcn_cvt_scalef32_pk_f32_fp4(va[j].x, 1.0f, 1);
        o2[2] += cc * __builtin_amdgcn_cvt_scalef32_pk_f32_fp4(va[j].x, 1.0f, 2);
        o2[3] += cc * __builtin_amdgcn_cvt_scalef32_pk_f32_fp4(va[j].x, 1.0f, 3);
        o2[4] += cc * __builtin_amdgcn_cvt_scalef32_pk_f32_fp4(va[j].y, 1.0f, 0);
        o2[5] += cc * __builtin_amdgcn_cvt_scalef32_pk_f32_fp4(va[j].y, 1.0f, 1);
        o2[6] += cc * __builtin_amdgcn_cvt_scalef32_pk_f32_fp4(va[j].y, 1.0f, 2);
        o2[7] += cc * __builtin_amdgcn_cvt_scalef32_pk_f32_fp4(va[j].y, 1.0f, 3);
      }
    }
    if (coop) {
      __syncthreads();
#pragma unroll
      for (int f4 = 0; f4 < 4; f4++)
        *(float4*)(part + wave * 1024 + lane * 16 + f4 * 4) = make_float4(o2[f4 * 2].x, o2[f4 * 2].y, o2[f4 * 2 + 1].x, o2[f4 * 2 + 1].y);
      __syncthreads();
      if (wave != 0) continue;
#pragma unroll
      for (int w = 1; w < 4; w++)
#pragma unroll
        for (int f4 = 0; f4 < 4; f4++) {
          const float4 v = *(const float4*)(part + w * 1024 + lane * 16 + f4 * 4);
          o2[f4 * 2].x += v.x; o2[f4 * 2].y += v.y; o2[f4 * 2 + 1].x += v.z; o2[f4 * 2 + 1].y += v.w;
        }
    }
    float* hp = H + (size_t)t * DM + lane * 16;
    float hn[16]; float ss = 0.f;
#pragma unroll
    for (int f4 = 0; f4 < 4; f4++) {
      const float4 v = *(const float4*)(hp + f4 * 4);
      const int i = f4 * 4;
      hn[i] = v.x + o2[f4 * 2].x; hn[i + 1] = v.y + o2[f4 * 2].y; hn[i + 2] = v.z + o2[f4 * 2 + 1].x; hn[i + 3] = v.w + o2[f4 * 2 + 1].y;
      ss += hn[i] * hn[i] + hn[i + 1] * hn[i + 1] + hn[i + 2] * hn[i + 2] + hn[i + 3] * hn[i + 3];
    }
    ss = wave_sum(ss);
    const float rstd = rsqrtf(ss * (1.f / 1024.f) + 1e-5f);
    float yn[16];
#pragma unroll
    for (int f4 = 0; f4 < 4; f4++) {
      const float4 g = *(const float4*)(gn + lane * 16 + f4 * 4);
      const int i = f4 * 4;
      yn[i] = hn[i] * rstd * g.x; yn[i + 1] = hn[i + 1] * rstd * g.y; yn[i + 2] = hn[i + 2] * rstd * g.z; yn[i + 3] = hn[i + 3] * rstd * g.w;
    }
    if (dry && rstd != 123.456f) continue;
    if (layer == 0) {
      bf16_t* xnm = (bf16_t*)(ws + OFF_XNM) + (size_t)t * DM + lane * 16;
#pragma unroll
      for (int f4 = 0; f4 < 4; f4++) *(float4*)(hp + f4 * 4) = make_float4(hn[f4 * 4], hn[f4 * 4 + 1], hn[f4 * 4 + 2], hn[f4 * 4 + 3]);
      *(uint4*)(xnm) = make_uint4(cvtpk(yn[0], yn[1]), cvtpk(yn[2], yn[3]), cvtpk(yn[4], yn[5]), cvtpk(yn[6], yn[7]));
      *(uint4*)(xnm + 8) = make_uint4(cvtpk(yn[8], yn[9]), cvtpk(yn[10], yn[11]), cvtpk(yn[12], yn[13]), cvtpk(yn[14], yn[15]));
    } else {
      float* dst = nullptr;
      if (t < TP) { const int b = t / LP, l = t - b * LP; if (l >= 16) dst = p.out + OUT0 + ((size_t)b * 2048 + (l - 16)) * DM; }
      else dst = p.out + OUT1 + (size_t)(t - TP) * DM;
      if (dst) {
#pragma unroll
        for (int f4 = 0; f4 < 4; f4++) *(float4*)(dst + lane * 16 + f4 * 4) = make_float4(yn[f4 * 4], yn[f4 * 4 + 1], yn[f4 * 4 + 2], yn[f4 * 4 + 3]);
      }
    }
  }
}

__device__ __forceinline__ void phase_mamba_inproj(const Params& p, char* smem) {
  bf16_t* sA = (bf16_t*)smem; bf16_t* sB = sA + 128 * SAS;
  char* ws = p.ws;
  bf16_t* Z = (bf16_t*)(ws + OFF_Z); bf16_t* XBC = (bf16_t*)(ws + OFF_XBC); float* DTR = (float*)(ws + OFF_DTR);
  for (int tile = blockIdx.x; tile < 133 * 41; tile += gridDim.x) {
    const int tm = tile / 41, tn = tile - tm * 41;
    GemmA ga; ga.A = (const bf16_t*)(ws + OFF_XNM); ga.lda = DM; ga.mix = nullptr; ga.sh0 = nullptr; ga.zero = nullptr;
    f32x16 acc[2][2];
    if (tn < 40) {
      gemm_mainloop<0, 1>(acc, ga, (const bf16_t*)(ws + WT_IN), 1024, 5152, 1024, tm * 128, tn * 128, sA, sB);
      if (tn < 16) gemm_epilogue_bf16_lds(acc, Z, 2048, tm * 128, tn * 128, 0, sA, [&](int, float v) { return v; });
      else gemm_epilogue_bf16_lds(acc, XBC, 3072, tm * 128, tn * 128 - 2048, 0, sA, [&](int, float v) { return v; });
      continue;
    }
    gemm_mainloop<0>(acc, ga, (const bf16_t*)(ws + WT_IN), 1024, 5152, 1024, tm * 128, tn * 128, sA, sB);
    if (tn < 16) {
      gemm_epilogue(acc, tm * 128, tn * 128, [&](int row, int col, float v) { Z[(size_t)row * 2048 + col] = f2bf(v); });
    } else if (tn < 40) {
      gemm_epilogue(acc, tm * 128, tn * 128 - 2048, [&](int row, int col, float v) { XBC[(size_t)row * 3072 + col] = f2bf(v); });
    } else {
      gemm_epilogue(acc, tm * 128, 0, [&](int row, int col, float v) { if (col < 32) DTR[(size_t)row * 32 + col] = v; });
    }
  }
}

__device__ __forceinline__ void phase_mamba_conv(const Params& p) {
  char* ws = p.ws;
  const bf16_t* XBC = (const bf16_t*)(ws + OFF_XBC);
  bf16_t* XC = (bf16_t*)(ws + OFF_XC);
  const float* cw = p.in[27]; const float* cb = p.in[28];
  for (int it = blockIdx.x * 256 + threadIdx.x; it < TT * 384; it += gridDim.x * 256) {
    const int t = it / 384, c8 = (it - t * 384) * 8;
    int b, l; const float* c0 = nullptr;
    if (t < TP) { b = t / LP; l = t - b * LP; } else { const int s = t - TP; b = s >> 2; l = s & 3; c0 = p.in[4] + (size_t)b * 9216; }
    float acc[8];
    {
      const float4 b0 = *(const float4*)(cb + c8), b1 = *(const float4*)(cb + c8 + 4);
      acc[0] = b0.x; acc[1] = b0.y; acc[2] = b0.z; acc[3] = b0.w; acc[4] = b1.x; acc[5] = b1.y; acc[6] = b1.z; acc[7] = b1.w;
    }
#pragma unroll
    for (int j = 0; j < 4; j++) {
      const int ll = l - 3 + j;
      float x[8];
      if (ll >= 0) {
        unpack8(*(const uint4*)(XBC + (size_t)(t - 3 + j) * 3072 + c8), x);
      } else if (c0) {
        const float4 v0 = *(const float4*)(c0 + (3 + ll) * 3072 + c8), v1 = *(const float4*)(c0 + (3 + ll) * 3072 + c8 + 4);
        x[0] = v0.x; x[1] = v0.y; x[2] = v0.z; x[3] = v0.w; x[4] = v1.x; x[5] = v1.y; x[6] = v1.z; x[7] = v1.w;
      } else {
#pragma unroll
        for (int e = 0; e < 8; e++) x[e] = 0.f;
      }
      const float4 w0 = *(const float4*)(cw + j * 3072 + c8), w1 = *(const float4*)(cw + j * 3072 + c8 + 4);
      acc[0] += w0.x * x[0]; acc[1] += w0.y * x[1]; acc[2] += w0.z * x[2]; acc[3] += w0.w * x[3];
      acc[4] += w1.x * x[4]; acc[5] += w1.y * x[5]; acc[6] += w1.z * x[6]; acc[7] += w1.w * x[7];
    }
#pragma unroll
    for (int e = 0; e < 8; e++) acc[e] = acc[e] * sigmoidf_(acc[e]);
    *(uint4*)(XC + (size_t)t * 3072 + c8) = pack8(acc);
  }
}

#define MCH 16
#define MSTRIDE (MCH * 136 * 2 + MCH * 64 * 2 + 2 * MCH)
__device__ __forceinline__ int padn(int n) { return n + ((n >> 6) << 2); }
struct MVec { float4 B[4], C[4]; float2 xx; float dt, dA; };
__device__ __forceinline__ void mamba_ld(MVec& m, const float* sB, int st, int nq, int pp) {
#pragma unroll
  for (int j4 = 0; j4 < 4; j4++) {
    m.B[j4] = *(const float4*)(sB + st * 136 + padn(nq * 16 + j4 * 4));
    m.C[j4] = *(const float4*)(sB + MCH * 136 + st * 136 + padn(nq * 16 + j4 * 4));
  }
  m.xx = *(const float2*)(sB + 2 * MCH * 136 + st * 64 + 2 * pp);
  m.dt = sB[2 * MCH * 136 + 2 * MCH * 64 + st];
  m.dA = sB[2 * MCH * 136 + 2 * MCH * 64 + MCH + st];
}
__device__ __forceinline__ float2 mamba_step(f32x2_t (&hs)[2][8], const MVec& m, float Dk) {
  const float xd0 = m.xx.x * m.dt, xd1 = m.xx.y * m.dt;
  const f32x2_t dA2 = f32x2_t{m.dA, m.dA}, xd0v = f32x2_t{xd0, xd0}, xd1v = f32x2_t{xd1, xd1};
  f32x2_t y0 = f32x2_t{0.f, 0.f}, y1 = f32x2_t{0.f, 0.f};
#pragma unroll
  for (int j4 = 0; j4 < 4; j4++) {
    const f32x2_t Ba = f32x2_t{m.B[j4].x, m.B[j4].y}, Bb = f32x2_t{m.B[j4].z, m.B[j4].w};
    const f32x2_t Ca = f32x2_t{m.C[j4].x, m.C[j4].y}, Cb = f32x2_t{m.C[j4].z, m.C[j4].w};
    const int j = j4 * 2;
    hs[0][j] = hs[0][j] * dA2 + xd0v * Ba; hs[0][j + 1] = hs[0][j + 1] * dA2 + xd0v * Bb;
    hs[1][j] = hs[1][j] * dA2 + xd1v * Ba; hs[1][j + 1] = hs[1][j + 1] * dA2 + xd1v * Bb;
    y0 += Ca * hs[0][j]; y0 += Cb * hs[0][j + 1];
    y1 += Ca * hs[1][j]; y1 += Cb * hs[1][j + 1];
  }
  const float ys0 = oct_sum(y0.x + y0.y), ys1 = oct_sum(y1.x + y1.y);
  return make_float2(ys0 + Dk * m.xx.x, ys1 + Dk * m.xx.y);
}
__device__ __forceinline__ void mamba_scan_item(const Params& p, int item, float* sm) {
  const int tid = threadIdx.x;
  char* ws = p.ws;
  int b, hd, L, t0; const float* h0; float* hout;
  if (item < 256) { b = item >> 5; hd = item & 31; L = LP; t0 = b * LP; h0 = nullptr; hout = p.out + OUT5 + (size_t)item * 8192; }
  else { int s = item - 256; b = s >> 5; hd = s & 31; L = 4; t0 = TP + b * 4; h0 = p.in[5] + (size_t)s * 8192; hout = p.out + OUT9 + (size_t)s * 8192; }
  const int g = hd >> 3;
  const int pp = tid >> 3, nq = tid & 7;
  f32x2_t hs[2][8];
#pragma unroll
  for (int i = 0; i < 2; i++)
#pragma unroll
    for (int j4 = 0; j4 < 4; j4++) {
      float4 v = make_float4(0.f, 0.f, 0.f, 0.f);
      if (h0) v = *(const float4*)(h0 + (2 * pp + i) * 128 + nq * 16 + j4 * 4);
      hs[i][j4 * 2] = f32x2_t{v.x, v.y}; hs[i][j4 * 2 + 1] = f32x2_t{v.z, v.w};
    }
  const float dtb = p.in[29][hd], Aneg = -__expf(p.in[30][hd]), Dk = p.in[31][hd];
  const bf16_t* XC = (const bf16_t*)(ws + OFF_XC);
  const float* DTR = (const float*)(ws + OFF_DTR);
  bf16_t* Y2 = (bf16_t*)(ws + OFF_Y2);
  const int fst = tid >> 4, fq = tid & 15;
  struct PF { uint4 fB, fC; uint2 fX; float dtr; };
  PF pfA, pfB;
  auto prefetch = [&](PF& f, int c0) {
    if (c0 + fst < L) {
      const size_t tok = (size_t)(t0 + c0 + fst);
      f.fB = *(const uint4*)(XC + tok * 3072 + 2048 + g * 128 + fq * 8);
      f.fC = *(const uint4*)(XC + tok * 3072 + 2560 + g * 128 + fq * 8);
      f.fX = *(const uint2*)(XC + tok * 3072 + hd * 64 + fq * 4);
      if (fq == 0) f.dtr = DTR[tok * 32 + hd];
    }
  };
  auto chunk = [&](PF& f, int c0, int par) {
    float* sB = sm + par * MSTRIDE;
    float* sYv = sB + 2 * MCH * 136 + MCH * 64;
    if (c0 + fst < L) {
      float v[8];
      unpack8(f.fB, v);
      *(float4*)(sB + fst * 136 + padn(fq * 8)) = make_float4(v[0], v[1], v[2], v[3]);
      *(float4*)(sB + fst * 136 + padn(fq * 8 + 4)) = make_float4(v[4], v[5], v[6], v[7]);
      unpack8(f.fC, v);
      *(float4*)(sB + MCH * 136 + fst * 136 + padn(fq * 8)) = make_float4(v[0], v[1], v[2], v[3]);
      *(float4*)(sB + MCH * 136 + fst * 136 + padn(fq * 8 + 4)) = make_float4(v[4], v[5], v[6], v[7]);
      *(float4*)(sB + 2 * MCH * 136 + fst * 64 + fq * 4) = make_float4(bflo(f.fX.x), bfhi(f.fX.x), bflo(f.fX.y), bfhi(f.fX.y));
      if (fq == 0) {
        const float dt = softplusf_(f.dtr + dtb);
        sB[2 * MCH * 136 + 2 * MCH * 64 + fst] = dt;
        sB[2 * MCH * 136 + 2 * MCH * 64 + MCH + fst] = __expf(dt * Aneg);
      }
    }
    __syncthreads();
    if (c0 + 2 * MCH < L) prefetch(f, c0 + 2 * MCH);
    const int nst = min(MCH, L - c0);
    MVec ma, mb;
    mamba_ld(ma, sB, 0, nq, pp);
    for (int st = 0; st < nst; st += 2) {
      mamba_ld(mb, sB, st + 1, nq, pp);
      const float2 ya = mamba_step(hs, ma, Dk);
      if (nq == 0) *(float2*)(sYv + st * 64 + 2 * pp) = ya;
      if (st + 2 < nst) mamba_ld(ma, sB, st + 2, nq, pp);
      const float2 yb = mamba_step(hs, mb, Dk);
      if (nq == 0) *(float2*)(sYv + (st + 1) * 64 + 2 * pp) = yb;
    }
    __syncthreads();
    if (c0 + fst < L) {
      const float4 v = *(const float4*)(sYv + fst * 64 + fq * 4);
      *(uint2*)(Y2 + (size_t)(t0 + c0 + fst) * 2048 + hd * 64 + fq * 4) = make_uint2(cvtpk(v.x, v.y), cvtpk(v.z, v.w));
    }
  };
  prefetch(pfA, 0);
  if (MCH < L) prefetch(pfB, MCH);
  for (int c0 = 0; c0 < L; c0 += 2 * MCH) {
    chunk(pfA, c0, 0);
    if (c0 + MCH < L) chunk(pfB, c0 + MCH, 1);
  }
#pragma unroll
  for (int i = 0; i < 2; i++)
#pragma unroll
    for (int j4 = 0; j4 < 4; j4++)
      *(float4*)(hout + (2 * pp + i) * 128 + nq * 16 + j4 * 4) =
          make_float4(hs[i][j4 * 2].x, hs[i][j4 * 2].y, hs[i][j4 * 2 + 1].x, hs[i][j4 * 2 + 1].y);
  __syncthreads();
}

#define MQ 64
__device__ __forceinline__ bf16x8 pack_acc8(const f32x16& a, int o) {
  uint4 u = make_uint4(cvtpk(a[o], a[o + 1]), cvtpk(a[o + 2], a[o + 3]), cvtpk(a[o + 4], a[o + 5]), cvtpk(a[o + 6], a[o + 7]));
  return __builtin_bit_cast(bf16x8, u);
}
__device__ __forceinline__ void mamba_chunk_item(const Params& p, int item, char* smem) {
  const int tid = threadIdx.x, lane = tid & 63, wave = tid >> 6;
  const int l31 = lane & 31, g2 = lane >> 5;
  char* ws = p.ws;
  const int b = item >> 5, hd = item & 31, g = hd >> 3;
  const int t0 = b * LP;
  bf16_t* Cs = (bf16_t*)smem;
  bf16_t* Bs = Cs + 64 * 136;
  bf16_t* Ms = Bs;
  bf16_t* Bt = Bs + 64 * 136;
  bf16_t* Xt = Bt + 128 * 72;
  bf16_t* Xt2 = Xt + 64 * 72;
  float* sCs = (float*)(Xt2 + 64 * 72);
  float* sDt = sCs + 64;
  const float dtb = p.in[29][hd], Aneg = -__expf(p.in[30][hd]), Dk = p.in[31][hd];
  const bf16_t* XC = (const bf16_t*)(ws + OFF_XC);
  const float* DTR = (const float*)(ws + OFF_DTR);
  bf16_t* Y2 = (bf16_t*)(ws + OFF_Y2);
  const int wi = wave >> 1, wj = wave & 1;
  f32x16 hT[4];
#pragma unroll
  for (int nb = 0; nb < 4; nb++)
#pragma unroll
    for (int r = 0; r < 16; r++) hT[nb][r] = 0.f;
  const int fs = tid >> 2, q4 = tid & 3;
  uint4 fC[4], fB[4], fX[2]; float fdt = 0.f;
  auto prefetch = [&](int c0) {
    const bool valid = (c0 + fs) < LP;
    const bf16_t* rowp = XC + (size_t)(t0 + c0 + fs) * 3072;
#pragma unroll
    for (int i = 0; i < 4; i++) {
      const int q = q4 * 4 + i;
      fC[i] = valid ? *(const uint4*)(rowp + 2560 + g * 128 + q * 8) : make_uint4(0, 0, 0, 0);
      fB[i] = valid ? *(const uint4*)(rowp + 2048 + g * 128 + q * 8) : make_uint4(0, 0, 0, 0);
    }
#pragma unroll
    for (int i = 0; i < 2; i++) {
      const int q = q4 * 2 + i;
      fX[i] = valid ? *(const uint4*)(rowp + hd * 64 + q * 8) : make_uint4(0, 0, 0, 0);
    }
    if (wave == 0) fdt = ((c0 + lane) < LP) ? DTR[(size_t)(t0 + c0 + lane) * 32 + hd] : -1e30f;
  };
  prefetch(0);
  for (int c0 = 0; c0 < LP; c0 += MQ) {
    if (wave == 0) {
      const float dt = (c0 + lane < LP) ? softplusf_(fdt + dtb) : 0.f;
      float cs = dt * Aneg;
#pragma unroll
      for (int d = 1; d < 64; d <<= 1) { const float o = __shfl_up(cs, d); if (lane >= d) cs += o; }
      sCs[lane] = cs; sDt[lane] = dt;
    }
#pragma unroll
    for (int i = 0; i < 4; i++) {
      const int q = q4 * 4 + i;
      *(uint4*)(Cs + fs * 136 + q * 8) = fC[i];
      *(uint4*)(Bs + fs * 136 + q * 8) = fB[i];
      const unsigned w[4] = {fB[i].x, fB[i].y, fB[i].z, fB[i].w};
#pragma unroll
      for (int e = 0; e < 4; e++) {
        Bt[(q * 8 + 2 * e) * 72 + fs] = (bf16_t)(w[e] & 0xffffu);
        Bt[(q * 8 + 2 * e + 1) * 72 + fs] = (bf16_t)(w[e] >> 16);
      }
    }
    __syncthreads();
    {
      const float csQ = sCs[63];
      const float sc = sDt[fs] * __expf(csQ - sCs[fs]);
#pragma unroll
      for (int i = 0; i < 2; i++) {
        const int q = q4 * 2 + i;
        const unsigned w[4] = {fX[i].x, fX[i].y, fX[i].z, fX[i].w};
#pragma unroll
        for (int e = 0; e < 4; e++) {
          Xt[(q * 8 + 2 * e) * 72 + fs] = (bf16_t)(w[e] & 0xffffu);
          Xt[(q * 8 + 2 * e + 1) * 72 + fs] = (bf16_t)(w[e] >> 16);
          const unsigned pk = cvtpk(bflo(w[e]) * sc, bfhi(w[e]) * sc);
          Xt2[(q * 8 + 2 * e) * 72 + fs] = (bf16_t)(pk & 0xffffu);
          Xt2[(q * 8 + 2 * e + 1) * 72 + fs] = (bf16_t)(pk >> 16);
        }
      }
    }
    if (c0 + MQ < LP) prefetch(c0 + MQ);
    f32x16 gacc;
#pragma unroll
    for (int r = 0; r < 16; r++) gacc[r] = 0.f;
    const bool doG = !(wi == 0 && wj == 1);
    if (doG) {
#pragma unroll
      for (int ks = 0; ks < 8; ks++) {
        const bf16x8 a = *(const bf16x8*)(Cs + (wi * 32 + l31) * 136 + ks * 16 + g2 * 8);
        const bf16x8 bb = *(const bf16x8*)(Bs + (wj * 32 + l31) * 136 + ks * 16 + g2 * 8);
        gacc = __builtin_amdgcn_mfma_f32_32x32x16_bf16(a, bb, gacc, 0, 0, 0);
      }
    }
    f32x16 yacc;
#pragma unroll
    for (int r = 0; r < 16; r++) yacc[r] = 0.f;
#pragma unroll
    for (int nb = 0; nb < 4; nb++)
#pragma unroll
      for (int kk = 0; kk < 2; kk++) {
        const bf16_t* cp = Cs + (wi * 32 + l31) * 136 + nb * 32 + kk * 16 + 4 * g2;
        const uint2 lo = *(const uint2*)(cp), hi = *(const uint2*)(cp + 8);
        const uint4 au = make_uint4(lo.x, lo.y, hi.x, hi.y);
        yacc = __builtin_amdgcn_mfma_f32_32x32x16_bf16(__builtin_bit_cast(bf16x8, au), pack_acc8(hT[nb], kk * 8), yacc, 0, 0, 0);
      }
    __syncthreads();
    if (doG) {
      const int scol = wj * 32 + l31;
      const float cs_s = sCs[scol], dt_s = sDt[scol];
#pragma unroll
      for (int r = 0; r < 16; r++) {
        const int l = wi * 32 + g2 * 4 + (r & 3) + 8 * (r >> 2);
        float v = 0.f;
        if (scol <= l) v = gacc[r] * __expf(sCs[l] - cs_s) * dt_s;
        if (scol == l) v += Dk;
        Ms[l * 72 + scol] = f2bf(v);
      }
    } else {
#pragma unroll
      for (int r = 0; r < 16; r++) {
        const int l = g2 * 4 + (r & 3) + 8 * (r >> 2);
        Ms[l * 72 + 32 + l31] = 0;
      }
    }
#pragma unroll
    for (int r = 0; r < 16; r++) {
      const int l = wi * 32 + g2 * 4 + (r & 3) + 8 * (r >> 2);
      yacc[r] *= __expf(sCs[l]);
    }
    __syncthreads();
#pragma unroll
    for (int ks = 0; ks < 4; ks++) {
      const bf16x8 a = *(const bf16x8*)(Ms + (wi * 32 + l31) * 72 + ks * 16 + g2 * 8);
      const bf16x8 bb = *(const bf16x8*)(Xt + (wj * 32 + l31) * 72 + ks * 16 + g2 * 8);
      yacc = __builtin_amdgcn_mfma_f32_32x32x16_bf16(a, bb, yacc, 0, 0, 0);
    }
#pragma unroll
    for (int r = 0; r < 16; r++) {
      const int l = wi * 32 + g2 * 4 + (r & 3) + 8 * (r >> 2);
      if (c0 + l < LP) Y2[(size_t)(t0 + c0 + l) * 2048 + hd * 64 + wj * 32 + l31] = f2bf(yacc[r]);
    }
    {
      const float dec = __expf(sCs[63]);
#pragma unroll
      for (int nb = 0; nb < 4; nb++) {
#pragma unroll
        for (int r = 0; r < 16; r++) hT[nb][r] *= dec;
#pragma unroll
        for (int ks = 0; ks < 4; ks++) {
          const bf16x8 a = *(const bf16x8*)(Bt + (nb * 32 + l31) * 72 + ks * 16 + g2 * 8);
          const bf16x8 bb = *(const bf16x8*)(Xt2 + (wj * 32 + l31) * 72 + ks * 16 + g2 * 8);
          hT[nb] = __builtin_amdgcn_mfma_f32_32x32x16_bf16(a, bb, hT[nb], 0, 0, 0);
        }
      }
    }
    __syncthreads();
  }
  if (wi == 0) {
    float* hout = p.out + OUT5 + (size_t)item * 8192;
#pragma unroll
    for (int nb = 0; nb < 4; nb++)
#pragma unroll
      for (int r = 0; r < 16; r++) {
        const int n = nb * 32 + 8 * (r >> 2) + 4 * g2 + (r & 3);
        hout[(wj * 32 + l31) * 128 + n] = hT[nb][r];
      }
  }
}

__device__ __forceinline__ void phase_mamba_scan(const Params& p, char* smem) {
  const int nb = gridDim.x, bid = blockIdx.x;
  {
    const bf16_t* XBC = (const bf16_t*)(p.ws + OFF_XBC);
    for (int i = bid * 256 + threadIdx.x; i < (8 + 128) * 9216; i += nb * 256) {
      if (i < 8 * 9216) {
        const int b = i / 9216, r = i - b * 9216, j = r / 3072, c = r - j * 3072;
        p.out[OUT4 + i] = bf2f(XBC[(size_t)(b * LP + LP - 3 + j) * 3072 + c]);
      } else {
        const int ii = i - 8 * 9216;
        const int b = ii / 9216, r = ii - b * 9216, j = r / 3072, c = r - j * 3072;
        p.out[OUT8 + ii] = bf2f(XBC[(size_t)(TP + b * 4 + 1 + j) * 3072 + c]);
      }
    }
  }
  if (nb > 320) {
    if (bid < 256) mamba_chunk_item(p, bid, smem);
    else {
      for (int it = bid; it < 256 + 4096; it += nb - 256) mamba_scan_item(p, it, (float*)smem);
      convert_tables_fp8(p, bid - 256, nb - 256, 1);
    }
  } else {
    for (int it = bid; it < 256; it += nb) mamba_chunk_item(p, it, smem);
    for (int it = 256 + bid; it < 256 + 4096; it += nb) mamba_scan_item(p, it, (float*)smem);
    convert_tables_fp8(p, bid, nb, 1);
  }
}

__device__ __forceinline__ void phase_mamba_gate(const Params& p) {
  const int tid = threadIdx.x, lane = tid & 63, wave = tid >> 6;
  char* ws = p.ws;
  const bf16_t* Y2 = (const bf16_t*)(ws + OFF_Y2); const bf16_t* Z = (const bf16_t*)(ws + OFF_Z);
  bf16_t* YG = (bf16_t*)(ws + OFF_YG);
  const float* nw = p.in[32];
  for (int t = blockIdx.x * 4 + wave; t < TT; t += gridDim.x * 4) {
#pragma unroll
    for (int c = 0; c < 4; c++) {
      const size_t off = (size_t)t * 2048 + c * 512 + lane * 8;
      const uint4 yv = *(const uint4*)(Y2 + off), zv = *(const uint4*)(Z + off);
      float y[8], z[8];
      y[0] = bflo(yv.x); y[1] = bfhi(yv.x); y[2] = bflo(yv.y); y[3] = bfhi(yv.y); y[4] = bflo(yv.z); y[5] = bfhi(yv.z); y[6] = bflo(yv.w); y[7] = bfhi(yv.w);
      z[0] = bflo(zv.x); z[1] = bfhi(zv.x); z[2] = bflo(zv.y); z[3] = bfhi(zv.y); z[4] = bflo(zv.z); z[5] = bfhi(zv.z); z[6] = bflo(zv.w); z[7] = bfhi(zv.w);
      float ss = 0.f;
#pragma unroll
      for (int e = 0; e < 8; e++) { y[e] = y[e] * z[e] * sigmoidf_(z[e]); ss += y[e] * y[e]; }
      ss = wave_sum(ss);
      const float rstd = rsqrtf(ss * (1.f / 512.f) + 1e-5f);
      const float4 w0 = *(const float4*)(nw + c * 512 + lane * 8), w1 = *(const float4*)(nw + c * 512 + lane * 8 + 4);
      *(uint4*)(YG + off) = make_uint4(cvtpk(y[0] * rstd * w0.x, y[1] * rstd * w0.y), cvtpk(y[2] * rstd * w0.z, y[3] * rstd * w0.w),
                                       cvtpk(y[4] * rstd * w1.x, y[5] * rstd * w1.y), cvtpk(y[6] * rstd * w1.z, y[7] * rstd * w1.w));
    }
  }
}


#define XB_TMO      128
#define XB_XCNT(j)  (256  + 64 * (j))
#define XB_XSUB(j)  (1280 + 64 * (j))
#define XB_XGEN(j)  (2304 + 64 * (j))
#define XB_TOP      3328
#define XB_TOPGEN   3392
#define XCD_BAR_WORDS 3456
#define XB_SPIN_CAP (1u << 20)
#define LAS __attribute__((address_space(3)))
__device__ __forceinline__ unsigned xb_ld(unsigned* p)              { return __hip_atomic_load(p, __ATOMIC_RELAXED, __HIP_MEMORY_SCOPE_AGENT); }
__device__ __forceinline__ unsigned xb_add(unsigned* p, unsigned v) { return __hip_atomic_fetch_add(p, v, __ATOMIC_RELAXED, __HIP_MEMORY_SCOPE_AGENT); }
__device__ __forceinline__ unsigned xb_xcc_id() { return (unsigned)__builtin_amdgcn_s_getreg((3 << 11) | 20) & 0xFu; }
#define XB_SPIN(cond, bar) do { unsigned _sp = 0; while (cond) { __builtin_amdgcn_s_sleep(1); \
    if ((++_sp & 255u) == 0u) { if (xb_ld(&(bar)[XB_TMO])) break; if (_sp > XB_SPIN_CAP) { atomicAdd(&(bar)[XB_TMO], 1u); break; } } } } while (0)
struct XcdBarrier { unsigned* bar; unsigned x; volatile LAS unsigned* st; };
__device__ __forceinline__ XcdBarrier xcd_barrier_post(unsigned* bar, volatile LAS unsigned* st) {
  XcdBarrier b; b.bar = bar; b.x = xb_xcc_id(); b.st = st;
  if (threadIdx.x == 0) (void)xb_add(&bar[XB_XCNT(b.x)], 1u);
  return b;
}
__device__ __forceinline__ void xcd_barrier_complete(unsigned* bar, unsigned x, unsigned& nloc, unsigned& nx) {
  const unsigned G = gridDim.x * gridDim.y * gridDim.z;
  unsigned sum, cnt, mine, sp = 0u;
  for (;;) {
    sum = 0u; cnt = 0u; mine = 0u;
#pragma unroll
    for (unsigned j = 0; j < 16; ++j) { const unsigned c = xb_ld(&bar[XB_XCNT(j)]); sum += c; cnt += (c > 0u) ? 1u : 0u; mine = (j == x) ? c : mine; }
    if (sum == G) break;
    __builtin_amdgcn_s_sleep(1);
    if ((++sp & 255u) == 0u) { if (xb_ld(&bar[XB_TMO])) break; if (sp > XB_SPIN_CAP) { atomicAdd(&bar[XB_TMO], 1u); break; } }
  }
  nloc = mine > 0u ? mine : 1u; nx = cnt > 0u ? cnt : 1u;
}
__device__ __forceinline__ void xcd_barrier(const XcdBarrier& b) {
  asm volatile("s_waitcnt vmcnt(0)" ::: "memory");
  __syncthreads();
  if (threadIdx.x == 0) {
    unsigned* bar = b.bar;
    __builtin_amdgcn_s_waitcnt(0);
    unsigned nloc = b.st[0], nx = b.st[1];
    if (nloc == 0u) { xcd_barrier_complete(bar, b.x, nloc, nx); b.st[0] = nloc; b.st[1] = nx; }
    const unsigned old = xb_add(&bar[XB_XSUB(b.x)], 1u);
    const unsigned gen = old / nloc;
    if (old + 1u == (gen + 1u) * nloc) {
      __builtin_amdgcn_fence(__ATOMIC_RELEASE, "agent");
      asm volatile("s_waitcnt vmcnt(0)" ::: "memory");
      const unsigned og = xb_add(&bar[XB_TOP], 1u);
      const unsigned tg = og / nx;
      if (og + 1u == (tg + 1u) * nx) xb_add(&bar[XB_TOPGEN], 1u);
      else XB_SPIN(xb_ld(&bar[XB_TOPGEN]) == tg, bar);
      __builtin_amdgcn_fence(__ATOMIC_ACQUIRE, "agent");
      xb_add(&bar[XB_XGEN(b.x)], 1u);
      asm volatile("s_waitcnt vmcnt(0)" ::: "memory");
    } else {
      XB_SPIN(xb_ld(&bar[XB_XGEN(b.x)]) == gen, bar);
      __builtin_amdgcn_fence(__ATOMIC_ACQUIRE, "agent");
      asm volatile("s_waitcnt vmcnt(0)" ::: "memory");
    }
  }
  __syncthreads();
}

__global__ void __launch_bounds__(256, 2) fwd_megakernel(Params p) {
  __shared__ __attribute__((aligned(16))) char smem[73728];
  __shared__ uint4 xb_words;
  cg::grid_group grid = cg::this_grid();
  XcdBarrier xb;
  xb.bar = (unsigned*)(p.ws + OFF_BAR); xb.x = 0; xb.st = (volatile LAS unsigned*)&xb_words;
  if (p.phase_hi - p.phase_lo > 1) {
    if (threadIdx.x == 0) xb_words = make_uint4(0u, 0u, 0u, 0u);
    __syncthreads();
    xb = xcd_barrier_post((unsigned*)(p.ws + OFF_BAR), (volatile LAS unsigned*)&xb_words);
  }
#define PHASE(n_, call_)                                   \
  if (p.phase_lo <= (n_) && (n_) < p.phase_hi) {           \
    if ((n_) > p.phase_lo) {                               \
      if (p.phase_lo < 0) grid.sync(); else xcd_barrier(xb); \
    }                                                      \
    call_;                                                 \
  }
  PHASE(0, { if (PROBE & 16) phase0(p, smem); phase0(p, smem); })
  PHASE(1, { if (PROBE & 2) phase_rwkv_proj(p, smem); phase_rwkv_proj(p, smem); })
  PHASE(2, { if (PROBE & 2) phase_rwkv_lora2(p, smem); phase_rwkv_lora2(p, smem); })
  PHASE(3, phase_rwkv_prep(p, smem))
  PHASE(4, { if (PROBE & 64) phase_rwkv_scan(p, smem); phase_rwkv_scan(p, smem); })
  PHASE(5, phase_rwkv_out(p))
  PHASE(6, { if (PROBE & 2) phase_gemm_hadd(p, smem, (const bf16_t*)(p.ws + OFF_Y), DM, (const bf16_t*)(p.ws + WT_WO), 1024, true);
             phase_gemm_hadd(p, smem, (const bf16_t*)(p.ws + OFF_Y), DM, (const bf16_t*)(p.ws + WT_WO), 1024); })
  PHASE(7, { if (PROBE & 32) phase_peer_norm(p, 0); phase_peer_norm(p, 0); })
  PHASE(8, { if (PROBE & 8) phase_peer_query(p, 0, smem); phase_peer_query(p, 0, smem); })
  PHASE(9, phase_peer_route(p, 0))
  PHASE(10, { if (PROBE & 1) phase_peer_expert(p, 0, smem, true); phase_peer_expert(p, 0, smem); })
  PHASE(11, { if (PROBE & 2) phase_mamba_inproj(p, smem); phase_mamba_inproj(p, smem); })
  PHASE(12, phase_mamba_conv(p))
  PHASE(13, { if (PROBE & (4 | 128)) phase_mamba_scan(p, smem); phase_mamba_scan(p, smem); })
  PHASE(14, { if (PROBE & 32) phase_mamba_gate(p); phase_mamba_gate(p); })
  PHASE(15, { if (PROBE & 2) phase_gemm_hadd(p, smem, (const bf16_t*)(p.ws + OFF_YG), 2048, (const bf16_t*)(p.ws + WT_OUT), 2048, true);
              phase_gemm_hadd(p, smem, (const bf16_t*)(p.ws + OFF_YG), 2048, (const bf16_t*)(p.ws + WT_OUT), 2048); })
  PHASE(16, { if (PROBE & 32) phase_peer_norm(p, 1); phase_peer_norm(p, 1); })
  PHASE(17, { if (PROBE & 8) phase_peer_query(p, 1, smem); phase_peer_query(p, 1, smem); })
  PHASE(18, phase_peer_route(p, 1))
  PHASE(19, { if (PROBE & 1) phase_peer_expert(p, 1, smem, true); phase_peer_expert(p, 1, smem); })
}

extern "C" void kernel_launch(void* const* d_in, const int* in_sizes, int n_in, void* d_out, int out_size, void* d_ws,
                              size_t ws_size, hipStream_t stream) {
  static int grid_blocks = 0;
  if (!grid_blocks) {
    int dev = 0, cus = 0, per_cu = 0;
    (void)hipGetDevice(&dev);
    (void)hipDeviceGetAttribute(&cus, hipDeviceAttributeMultiprocessorCount, dev);
    (void)hipOccupancyMaxActiveBlocksPerMultiprocessor(&per_cu, fwd_megakernel, 256, 0);
    if (per_cu < 1) per_cu = 1;
    if (per_cu > 2) per_cu = 2;
    grid_blocks = cus * per_cu;
  }
  if (ws_size < WS_NEED) { fprintf(stderr, "workspace too small: %zu < %zu\n", ws_size, (size_t)WS_NEED); return; }
  Params p{};
  for (int i = 0; i < 38; i++) p.in[i] = (const float*)d_in[i];
  p.out = (float*)d_out;
  p.ws = (char*)d_ws;
#if MK_MULTI
  for (int ph = 0; ph < NPHASE; ph++) {
    p.phase_lo = ph; p.phase_hi = ph + 1;
    hipLaunchKernelGGL(fwd_megakernel, dim3(grid_blocks), dim3(256), 0, stream, p);
  }
#else
  p.phase_lo = 0; p.phase_hi = NPHASE;
  (void)hipMemsetAsync((char*)d_ws + OFF_BAR, 0, 16384, stream);
  void* args[] = {&p};
  hipError_t e = hipLaunchCooperativeKernel((void*)fwd_megakernel, dim3(grid_blocks), dim3(256), args, 0, stream);
  if (e != hipSuccess) fprintf(stderr, "cooperative launch failed: %s (grid %d)\n", hipGetErrorString(e), grid_blocks);
#endif
}
```

```cpp
#include <hip/hip_runtime.h>
#include <hip/hip_cooperative_groups.h>
#include <stdint.h>
#include <stdio.h>
namespace cg = cooperative_groups;

#ifndef PROBE
#define PROBE 0
#endif
#ifndef MK_MULTI
#define MK_MULTI 0
#endif

typedef unsigned short bf16_t;
typedef short bf16x8 __attribute__((ext_vector_type(8)));
typedef float f32x16 __attribute__((ext_vector_type(16)));
typedef float f32x2_t __attribute__((ext_vector_type(2)));
typedef __bf16 bf16x2_t __attribute__((ext_vector_type(2)));

#define DM 1024
#define LP 2064
#define TP 16512
#define TS 512
#define TT 17024
#define NPHASE 20

#define OUT0 0
#define OUT1 16777216
#define OUT2 17301504
#define OUT3 17309696
#define OUT4 17833984
#define OUT5 17907712
#define OUT6 20004864
#define OUT7 20135936
#define OUT8 28524544
#define OUT9 29704192

constexpr size_t UB = 34865152ull;
constexpr size_t OFF_H = 0;
constexpr size_t OFF_TAB = OFF_H + 2 * UB;
constexpr size_t OFF_WT = OFF_TAB + 67108864ull;
constexpr size_t WT_RKV = OFF_WT;
constexpr size_t WT_W1 = WT_RKV + 6291456;
constexpr size_t WT_A1 = WT_W1 + 131072;
constexpr size_t WT_G1 = WT_A1 + 131072;
constexpr size_t WT_W2 = WT_G1 + 393216;
constexpr size_t WT_A2 = WT_W2 + 131072;
constexpr size_t WT_G2 = WT_A2 + 131072;
constexpr size_t WT_WO = WT_G2 + 393216;
constexpr size_t WT_IN = WT_WO + 2097152;
constexpr size_t WT_OUT = WT_IN + 10551296;
constexpr size_t WT_Q = WT_OUT + 4194304;
constexpr size_t WT_SK = WT_Q + 8388608;
constexpr size_t WT_SH0 = WT_SK + 1048576;
constexpr size_t WT_ZERO = WT_SH0 + 262144;
constexpr size_t WT_SC = WT_ZERO + 2048;
constexpr size_t OFF_ARENA = OFF_WT + 34603008ull;
constexpr size_t RG(int i) { return OFF_ARENA + (size_t)i * UB; }
constexpr size_t OFF_L1W = RG(8);
constexpr size_t OFF_L1A = OFF_L1W + 2179072;
constexpr size_t OFF_L1G = OFF_L1A + 2179072;
constexpr size_t OFF_DTR = OFF_L1G + 6537216;
constexpr size_t OFF_BAR = OFF_DTR + 2179072;
constexpr size_t OFF_BON = OFF_BAR + 16384;
constexpr size_t OFF_BB = OFF_BON + 1089536;
constexpr size_t OFF_XC = OFF_BB;
constexpr size_t OFF_RSM = OFF_BB + UB;
constexpr size_t RSM_ITEM = 2304;
constexpr size_t OFF_RSP = OFF_RSM + 18560 * RSM_ITEM;
constexpr size_t WS_NEED = OFF_BB + 3 * UB;
static_assert(OFF_RSP + 2048ull * 10240 <= OFF_BB + 3 * UB, "rwkv packed region");
constexpr size_t OFF_XN = RG(0);
constexpr size_t OFF_Y = RG(0);
constexpr size_t OFF_R = RG(1), OFF_K = RG(2), OFF_V = RG(3);
constexpr size_t OFF_DEC = RG(4);
constexpr size_t OFF_A = RG(6), OFF_G = RG(7);
constexpr size_t OFF_XN2_0 = RG(1);
constexpr size_t OFF_KEYS_0 = RG(2);
constexpr size_t OFF_XNM = RG(0);
constexpr size_t OFF_Z = RG(1);
constexpr size_t OFF_XBC = RG(3);
constexpr size_t OFF_Y2 = RG(6);
constexpr size_t OFF_YG = RG(3);
constexpr size_t OFF_XN2_1 = RG(5);
constexpr size_t OFF_KEYS_1 = RG(0);

struct Params {
  const float* in[38];
  float* out;
  char* ws;
  int phase_lo, phase_hi;
};

__device__ __forceinline__ unsigned cvtpk(float lo, float hi) {
  f32x2_t v = {lo, hi};
  bf16x2_t b = __builtin_convertvector(v, bf16x2_t);
  return __builtin_bit_cast(unsigned, b);
}
__device__ __forceinline__ float bflo(unsigned u) { return __uint_as_float(u << 16); }
__device__ __forceinline__ float bfhi(unsigned u) { return __uint_as_float(u & 0xffff0000u); }
__device__ __forceinline__ float bf2f(bf16_t b) { return __uint_as_float(((unsigned)b) << 16); }
__device__ __forceinline__ bf16_t f2bf(float f) { return (bf16_t)(cvtpk(f, 0.f) & 0xffffu); }
__device__ __forceinline__ float dot2bf(unsigned a, unsigned b, float c) {
  return __builtin_amdgcn_fdot2_f32_bf16(__builtin_bit_cast(bf16x2_t, a), __builtin_bit_cast(bf16x2_t, b), c, false);
}
template <int CTRL> __device__ __forceinline__ float dpp_f(float v) {
  return __int_as_float(__builtin_amdgcn_update_dpp(0, __float_as_int(v), CTRL, 0xf, 0xf, true));
}
template <int CTRL> __device__ __forceinline__ int dpp_i(int v) {
  return __builtin_amdgcn_update_dpp(0, v, CTRL, 0xf, 0xf, true);
}
__device__ __forceinline__ float quad_sum(float v) { v += dpp_f<0xB1>(v); v += dpp_f<0x4E>(v); return v; }
__device__ __forceinline__ float oct_sum(float v) { v = quad_sum(v); v += dpp_f<0x141>(v); return v; }
__device__ __forceinline__ float row_sum(float v) { v = oct_sum(v); v += dpp_f<0x140>(v); return v; }
__device__ __forceinline__ float rdlane(float v, int l) { return __int_as_float(__builtin_amdgcn_readlane(__float_as_int(v), l)); }
__device__ __forceinline__ float wave_sum(float v) {
  v = row_sum(v);
  return (rdlane(v, 0) + rdlane(v, 16)) + (rdlane(v, 32) + rdlane(v, 48));
}
__device__ __forceinline__ float wave_max(float v) {
  v = fmaxf(v, dpp_f<0xB1>(v)); v = fmaxf(v, dpp_f<0x4E>(v)); v = fmaxf(v, dpp_f<0x141>(v)); v = fmaxf(v, dpp_f<0x140>(v));
  return fmaxf(fmaxf(rdlane(v, 0), rdlane(v, 16)), fmaxf(rdlane(v, 32), rdlane(v, 48)));
}
__device__ __forceinline__ float sigmoidf_(float x) { return 1.f / (1.f + __expf(-x)); }
__device__ __forceinline__ float softplusf_(float x) { return fmaxf(x, 0.f) + log1pf(__expf(-fabsf(x))); }
__device__ __forceinline__ int enc_key(float s) { int i = __float_as_int(s); return i ^ ((i >> 31) & 0x7fffffff); }
__device__ __forceinline__ float dec_key(int i) { return __int_as_float(i ^ ((i >> 31) & 0x7fffffff)); }

__device__ __forceinline__ void unpack8(const uint4 u, float (&f)[8]) {
  f[0] = bflo(u.x); f[1] = bfhi(u.x); f[2] = bflo(u.y); f[3] = bfhi(u.y); f[4] = bflo(u.z); f[5] = bfhi(u.z); f[6] = bflo(u.w); f[7] = bfhi(u.w);
}
__device__ __forceinline__ uint4 pack8(const float (&f)[8]) {
  return make_uint4(cvtpk(f[0], f[1]), cvtpk(f[2], f[3]), cvtpk(f[4], f[5]), cvtpk(f[6], f[7]));
}
#define INS16(L, x_)                          \
  {                                           \
    int xx = (x_);                            \
    _Pragma("unroll") for (int q_ = 0; q_ < 16; q_++) { \
      int hi_ = max(L[q_], xx);               \
      xx = min(L[q_], xx);                    \
      L[q_] = hi_;                            \
    }                                         \
  }

__device__ __forceinline__ void sort16_desc(int (&a)[16]) {
  { const int hi_ = max(a[0], a[1]), lo_ = min(a[0], a[1]); a[0] = hi_; a[1] = lo_; }
  { const int hi_ = max(a[2], a[3]), lo_ = min(a[2], a[3]); a[2] = lo_; a[3] = hi_; }
  { const int hi_ = max(a[4], a[5]), lo_ = min(a[4], a[5]); a[4] = hi_; a[5] = lo_; }
  { const int hi_ = max(a[6], a[7]), lo_ = min(a[6], a[7]); a[6] = lo_; a[7] = hi_; }
  { const int hi_ = max(a[8], a[9]), lo_ = min(a[8], a[9]); a[8] = hi_; a[9] = lo_; }
  { const int hi_ = max(a[10], a[11]), lo_ = min(a[10], a[11]); a[10] = lo_; a[11] = hi_; }
  { const int hi_ = max(a[12], a[13]), lo_ = min(a[12], a[13]); a[12] = hi_; a[13] = lo_; }
  { const int hi_ = max(a[14], a[15]), lo_ = min(a[14], a[15]); a[14] = lo_; a[15] = hi_; }
  { const int hi_ = max(a[0], a[2]), lo_ = min(a[0], a[2]); a[0] = hi_; a[2] = lo_; }
  { const int hi_ = max(a[1], a[3]), lo_ = min(a[1], a[3]); a[1] = hi_; a[3] = lo_; }
  { const int hi_ = max(a[4], a[6]), lo_ = min(a[4], a[6]); a[4] = lo_; a[6] = hi_; }
  { const int hi_ = max(a[5], a[7]), lo_ = min(a[5], a[7]); a[5] = lo_; a[7] = hi_; }
  { const int hi_ = max(a[8], a[10]), lo_ = min(a[8], a[10]); a[8] = hi_; a[10] = lo_; }
  { const int hi_ = max(a[9], a[11]), lo_ = min(a[9], a[11]); a[9] = hi_; a[11] = lo_; }
  { const int hi_ = max(a[12], a[14]), lo_ = min(a[12], a[14]); a[12] = lo_; a[14] = hi_; }
  { const int hi_ = max(a[13], a[15]), lo_ = min(a[13], a[15]); a[13] = lo_; a[15] = hi_; }
  { const int hi_ = max(a[0], a[1]), lo_ = min(a[0], a[1]); a[0] = hi_; a[1] = lo_; }
  { const int hi_ = max(a[2], a[3]), lo_ = min(a[2], a[3]); a[2] = hi_; a[3] = lo_; }
  { const int hi_ = max(a[4], a[5]), lo_ = min(a[4], a[5]); a[4] = lo_; a[5] = hi_; }
  { const int hi_ = max(a[6], a[7]), lo_ = min(a[6], a[7]); a[6] = lo_; a[7] = hi_; }
  { const int hi_ = max(a[8], a[9]), lo_ = min(a[8], a[9]); a[8] = hi_; a[9] = lo_; }
  { const int hi_ = max(a[10], a[11]), lo_ = min(a[10], a[11]); a[10] = hi_; a[11] = lo_; }
  { const int hi_ = max(a[12], a[13]), lo_ = min(a[12], a[13]); a[12] = lo_; a[13] = hi_; }
  { const int hi_ = max(a[14], a[15]), lo_ = min(a[14], a[15]); a[14] = lo_; a[15] = hi_; }
  { const int hi_ = max(a[0], a[4]), lo_ = min(a[0], a[4]); a[0] = hi_; a[4] = lo_; }
  { const int hi_ = max(a[1], a[5]), lo_ = min(a[1], a[5]); a[1] = hi_; a[5] = lo_; }
  { const int hi_ = max(a[2], a[6]), lo_ = min(a[2], a[6]); a[2] = hi_; a[6] = lo_; }
  { const int hi_ = max(a[3], a[7]), lo_ = min(a[3], a[7]); a[3] = hi_; a[7] = lo_; }
  { const int hi_ = max(a[8], a[12]), lo_ = min(a[8], a[12]); a[8] = lo_; a[12] = hi_; }
  { const int hi_ = max(a[9], a[13]), lo_ = min(a[9], a[13]); a[9] = lo_; a[13] = hi_; }
  { const int hi_ = max(a[10], a[14]), lo_ = min(a[10], a[14]); a[10] = lo_; a[14] = hi_; }
  { const int hi_ = max(a[11], a[15]), lo_ = min(a[11], a[15]); a[11] = lo_; a[15] = hi_; }
  { const int hi_ = max(a[0], a[2]), lo_ = min(a[0], a[2]); a[0] = hi_; a[2] = lo_; }
  { const int hi_ = max(a[1], a[3]), lo_ = min(a[1], a[3]); a[1] = hi_; a[3] = lo_; }
  { const int hi_ = max(a[4], a[6]), lo_ = min(a[4], a[6]); a[4] = hi_; a[6] = lo_; }
  { const int hi_ = max(a[5], a[7]), lo_ = min(a[5], a[7]); a[5] = hi_; a[7] = lo_; }
  { const int hi_ = max(a[8], a[10]), lo_ = min(a[8], a[10]); a[8] = lo_; a[10] = hi_; }
  { const int hi_ = max(a[9], a[11]), lo_ = min(a[9], a[11]); a[9] = lo_; a[11] = hi_; }
  { const int hi_ = max(a[12], a[14]), lo_ = min(a[12], a[14]); a[12] = lo_; a[14] = hi_; }
  { const int hi_ = max(a[13], a[15]), lo_ = min(a[13], a[15]); a[13] = lo_; a[15] = hi_; }
  { const int hi_ = max(a[0], a[1]), lo_ = min(a[0], a[1]); a[0] = hi_; a[1] = lo_; }
  { const int hi_ = max(a[2], a[3]), lo_ = min(a[2], a[3]); a[2] = hi_; a[3] = lo_; }
  { const int hi_ = max(a[4], a[5]), lo_ = min(a[4], a[5]); a[4] = hi_; a[5] = lo_; }
  { const int hi_ = max(a[6], a[7]), lo_ = min(a[6], a[7]); a[6] = hi_; a[7] = lo_; }
  { const int hi_ = max(a[8], a[9]), lo_ = min(a[8], a[9]); a[8] = lo_; a[9] = hi_; }
  { const int hi_ = max(a[10], a[11]), lo_ = min(a[10], a[11]); a[10] = lo_; a[11] = hi_; }
  { const int hi_ = max(a[12], a[13]), lo_ = min(a[12], a[13]); a[12] = lo_; a[13] = hi_; }
  { const int hi_ = max(a[14], a[15]), lo_ = min(a[14], a[15]); a[14] = lo_; a[15] = hi_; }
  { const int hi_ = max(a[0], a[8]), lo_ = min(a[0], a[8]); a[0] = hi_; a[8] = lo_; }
  { const int hi_ = max(a[1], a[9]), lo_ = min(a[1], a[9]); a[1] = hi_; a[9] = lo_; }
  { const int hi_ = max(a[2], a[10]), lo_ = min(a[2], a[10]); a[2] = hi_; a[10] = lo_; }
  { const int hi_ = max(a[3], a[11]), lo_ = min(a[3], a[11]); a[3] = hi_; a[11] = lo_; }
  { const int hi_ = max(a[4], a[12]), lo_ = min(a[4], a[12]); a[4] = hi_; a[12] = lo_; }
  { const int hi_ = max(a[5], a[13]), lo_ = min(a[5], a[13]); a[5] = hi_; a[13] = lo_; }
  { const int hi_ = max(a[6], a[14]), lo_ = min(a[6], a[14]); a[6] = hi_; a[14] = lo_; }
  { const int hi_ = max(a[7], a[15]), lo_ = min(a[7], a[15]); a[7] = hi_; a[15] = lo_; }
  { const int hi_ = max(a[0], a[4]), lo_ = min(a[0], a[4]); a[0] = hi_; a[4] = lo_; }
  { const int hi_ = max(a[1], a[5]), lo_ = min(a[1], a[5]); a[1] = hi_; a[5] = lo_; }
  { const int hi_ = max(a[2], a[6]), lo_ = min(a[2], a[6]); a[2] = hi_; a[6] = lo_; }
  { const int hi_ = max(a[3], a[7]), lo_ = min(a[3], a[7]); a[3] = hi_; a[7] = lo_; }
  { const int hi_ = max(a[8], a[12]), lo_ = min(a[8], a[12]); a[8] = hi_; a[12] = lo_; }
  { const int hi_ = max(a[9], a[13]), lo_ = min(a[9], a[13]); a[9] = hi_; a[13] = lo_; }
  { const int hi_ = max(a[10], a[14]), lo_ = min(a[10], a[14]); a[10] = hi_; a[14] = lo_; }
  { const int hi_ = max(a[11], a[15]), lo_ = min(a[11], a[15]); a[11] = hi_; a[15] = lo_; }
  { const int hi_ = max(a[0], a[2]), lo_ = min(a[0], a[2]); a[0] = hi_; a[2] = lo_; }
  { const int hi_ = max(a[1], a[3]), lo_ = min(a[1], a[3]); a[1] = hi_; a[3] = lo_; }
  { const int hi_ = max(a[4], a[6]), lo_ = min(a[4], a[6]); a[4] = hi_; a[6] = lo_; }
  { const int hi_ = max(a[5], a[7]), lo_ = min(a[5], a[7]); a[5] = hi_; a[7] = lo_; }
  { const int hi_ = max(a[8], a[10]), lo_ = min(a[8], a[10]); a[8] = hi_; a[10] = lo_; }
  { const int hi_ = max(a[9], a[11]), lo_ = min(a[9], a[11]); a[9] = hi_; a[11] = lo_; }
  { const int hi_ = max(a[12], a[14]), lo_ = min(a[12], a[14]); a[12] = hi_; a[14] = lo_; }
  { const int hi_ = max(a[13], a[15]), lo_ = min(a[13], a[15]); a[13] = hi_; a[15] = lo_; }
  { const int hi_ = max(a[0], a[1]), lo_ = min(a[0], a[1]); a[0] = hi_; a[1] = lo_; }
  { const int hi_ = max(a[2], a[3]), lo_ = min(a[2], a[3]); a[2] = hi_; a[3] = lo_; }
  { const int hi_ = max(a[4], a[5]), lo_ = min(a[4], a[5]); a[4] = hi_; a[5] = lo_; }
  { const int hi_ = max(a[6], a[7]), lo_ = min(a[6], a[7]); a[6] = hi_; a[7] = lo_; }
  { const int hi_ = max(a[8], a[9]), lo_ = min(a[8], a[9]); a[8] = hi_; a[9] = lo_; }
  { const int hi_ = max(a[10], a[11]), lo_ = min(a[10], a[11]); a[10] = hi_; a[11] = lo_; }
  { const int hi_ = max(a[12], a[13]), lo_ = min(a[12], a[13]); a[12] = hi_; a[13] = lo_; }
  { const int hi_ = max(a[14], a[15]), lo_ = min(a[14], a[15]); a[14] = hi_; a[15] = lo_; }
}
__device__ __forceinline__ void merge16_desc(int (&L)[16], const int (&b)[16]) {
#pragma unroll
  for (int j = 0; j < 16; j++) L[j] = max(L[j], b[15 - j]);
#define MSTAGE(d_)                                                                                          \
  _Pragma("unroll") for (int j = 0; j < 16; j++) if ((j & (d_)) == 0) {                                    \
    const int hi = max(L[j], L[j + (d_)]), lo = min(L[j], L[j + (d_)]); L[j] = hi; L[j + (d_)] = lo; }
  MSTAGE(8) MSTAGE(4) MSTAGE(2) MSTAGE(1)
#undef MSTAGE
}

__device__ __forceinline__ void transpose_job(const float* __restrict__ src, int K, int N, bf16_t* __restrict__ dst, int ldk,
                              int nrows, float* tile, int rot, int vb = -1, int vnb = 0) {
  const int tid = threadIdx.x;
  const int tk = ldk / 64, tn = (nrows + 63) / 64;
  const int nb = (vb < 0) ? (int)gridDim.x : vnb;
  const int bid = (((vb < 0) ? (int)blockIdx.x : vb) + rot) % nb;
  for (int tix = bid; tix < tk * tn; tix += nb) {
    const int k0 = (tix % tk) * 64, n0 = (tix / tk) * 64;
#pragma unroll
    for (int i = 0; i < 4; i++) {
      const int kl = (tid >> 4) + 16 * i, nl = (tid & 15) * 4;
      const int k = k0 + kl, n = n0 + nl;
      float4 v = make_float4(0.f, 0.f, 0.f, 0.f);
      if (k < K && n < N) v = *(const float4*)(src + (size_t)k * N + n);
      float* tp = tile + kl * 65 + nl;
      tp[0] = v.x; tp[1] = v.y; tp[2] = v.z; tp[3] = v.w;
    }
    __syncthreads();
    {
      const int nl = tid >> 2, kq = tid & 3;
      const int n = n0 + nl;
      if (n < nrows) {
        unsigned w[8];
#pragma unroll
        for (int j = 0; j < 8; j++)
          w[j] = cvtpk(tile[(kq * 16 + 2 * j) * 65 + nl], tile[(kq * 16 + 2 * j + 1) * 65 + nl]);
        uint4* dp = (uint4*)(dst + (size_t)n * ldk + k0 + kq * 16);
        dp[0] = make_uint4(w[0], w[1], w[2], w[3]);
        dp[1] = make_uint4(w[4], w[5], w[6], w[7]);
      }
    }
    __syncthreads();
  }
}

__device__ __forceinline__ void convert_linear(const float* __restrict__ src, bf16_t* __restrict__ dst, size_t n8, bool nt, int vb = -1, int vnb = 0) {
  typedef float f32x4n __attribute__((ext_vector_type(4)));
  const f32x4n* s = (const f32x4n*)src;
  uint4* d = (uint4*)dst;
  const size_t stride = (size_t)((vb < 0) ? (int)gridDim.x : vnb) * 256;
  for (size_t i = (size_t)((vb < 0) ? (int)blockIdx.x : vb) * 256 + threadIdx.x; i < n8; i += stride) {
    f32x4n a, b;
    if (nt) {
      a = __builtin_nontemporal_load(s + 2 * i);
      b = __builtin_nontemporal_load(s + 2 * i + 1);
    } else {
      a = s[2 * i]; b = s[2 * i + 1];
    }
    d[i] = make_uint4(cvtpk(a.x, a.y), cvtpk(a.z, a.w), cvtpk(b.x, b.y), cvtpk(b.z, b.w));
  }
}

__device__ __forceinline__ void convert_tables_fp8(const Params& p, int vb, int vnb, int layer) {
  typedef float f32x4n __attribute__((ext_vector_type(4)));
  const int lane = threadIdx.x & 63, wave = threadIdx.x >> 6;
  uint2* tab = (uint2*)(p.ws + OFF_TAB);
  float* sc = (float*)(p.ws + WT_SC);
  for (int r = layer * 32768 + vb * 4 + wave; r < (layer + 1) * 32768; r += vnb * 4) {
    const int which = r >> 14, row = r & 16383;
    const float* src = ((which & 1) ? p.in[37] : p.in[36]) + (size_t)(which >> 1) * 16777216 + (size_t)row * 1024;
    f32x4n v[4]; float am = 0.f;
#pragma unroll
    for (int i = 0; i < 4; i++) {
      v[i] = __builtin_nontemporal_load((const f32x4n*)src + lane * 4 + i);
      am = fmaxf(am, fmaxf(fmaxf(fabsf(v[i].x), fabsf(v[i].y)), fmaxf(fabsf(v[i].z), fabsf(v[i].w))));
    }
    am = wave_max(am);
    const float scale = am > 0.f ? 6.f / am : 0.f;
    unsigned w0 = 0, w1 = 0;
    w0 = __builtin_amdgcn_cvt_scalef32_pk_fp4_f32(w0, v[0].x * scale, v[0].y * scale, 1.0f, 0);
    w0 = __builtin_amdgcn_cvt_scalef32_pk_fp4_f32(w0, v[0].z * scale, v[0].w * scale, 1.0f, 1);
    w0 = __builtin_amdgcn_cvt_scalef32_pk_fp4_f32(w0, v[1].x * scale, v[1].y * scale, 1.0f, 2);
    w0 = __builtin_amdgcn_cvt_scalef32_pk_fp4_f32(w0, v[1].z * scale, v[1].w * scale, 1.0f, 3);
    w1 = __builtin_amdgcn_cvt_scalef32_pk_fp4_f32(w1, v[2].x * scale, v[2].y * scale, 1.0f, 0);
    w1 = __builtin_amdgcn_cvt_scalef32_pk_fp4_f32(w1, v[2].z * scale, v[2].w * scale, 1.0f, 1);
    w1 = __builtin_amdgcn_cvt_scalef32_pk_fp4_f32(w1, v[3].x * scale, v[3].y * scale, 1.0f, 2);
    w1 = __builtin_amdgcn_cvt_scalef32_pk_fp4_f32(w1, v[3].z * scale, v[3].w * scale, 1.0f, 3);
    tab[(size_t)r * 64 + lane] = make_uint2(w0, w1);
    if (lane == 0) sc[r] = am * (1.f / 6.f);
  }
}

__device__ __forceinline__ void phase0(const Params& p, char* smem) {
  const int tid = threadIdx.x, lane = tid & 63, wave = tid >> 6;
  const int nb = gridDim.x, bid = blockIdx.x;
  {
    float* H = (float*)(p.ws + OFF_H);
    bf16_t* XN = (bf16_t*)(p.ws + OFF_XN);
    const float4* g0 = (const float4*)p.in[7];
    for (int t = bid * 4 + wave; t < TT; t += nb * 4) {
      const float* src; int b, l;
      if (t < TP) {
        b = t / LP; l = t - b * LP;
        src = (l < 16) ? (p.in[6] + l * DM) : (p.in[0] + ((size_t)b * 2048 + (l - 16)) * DM);
      } else {
        int s = t - TP; b = s >> 2; l = s & 3; src = p.in[1] + (size_t)s * DM;
      }
      float4 v[4]; float ss = 0.f;
#pragma unroll
      for (int i = 0; i < 4; i++) {
        v[i] = ((const float4*)src)[i * 64 + lane];
        ss += v[i].x * v[i].x + v[i].y * v[i].y + v[i].z * v[i].z + v[i].w * v[i].w;
      }
      ss = wave_sum(ss);
      const float rstd = rsqrtf(ss * (1.f / 1024.f) + 1e-5f);
      float* sdst = nullptr;
      if (t < TP) { if (l == LP - 1) sdst = p.out + OUT2 + b * DM; }
      else if (l == 3) sdst = p.out + OUT6 + b * DM;
#pragma unroll
      for (int i = 0; i < 4; i++) {
        const float4 g = g0[i * 64 + lane];
        ((float4*)(H + (size_t)t * DM))[i * 64 + lane] = v[i];
        float4 xn = make_float4(v[i].x * rstd * g.x, v[i].y * rstd * g.y, v[i].z * rstd * g.z, v[i].w * rstd * g.w);
        ((uint2*)(XN + (size_t)t * DM))[i * 64 + lane] = make_uint2(cvtpk(xn.x, xn.y), cvtpk(xn.z, xn.w));
        if (sdst) ((float4*)sdst)[i * 64 + lane] = xn;
      }
    }
  }
  float* tile = (float*)smem;
  char* ws = p.ws;
  for (int j = 0; j < 3; j++)
    transpose_job(p.in[11] + (size_t)j * 1048576, 1024, 1024, (bf16_t*)(ws + WT_RKV) + (size_t)j * 1048576, 1024, 1024, tile, j * 37);
  transpose_job(p.in[13], 1024, 64, (bf16_t*)(ws + WT_W1), 1024, 64, tile, 11);
  transpose_job(p.in[16], 1024, 64, (bf16_t*)(ws + WT_A1), 1024, 64, tile, 29);
  transpose_job(p.in[18], 1024, 160, (bf16_t*)(ws + WT_G1), 1024, 192, tile, 47);
  transpose_job(p.in[14], 64, 1024, (bf16_t*)(ws + WT_W2), 64, 1024, tile, 95);
  transpose_job(p.in[17], 64, 1024, (bf16_t*)(ws + WT_A2), 64, 1024, tile, 111);
  transpose_job(p.in[19], 160, 1024, (bf16_t*)(ws + WT_G2), 192, 1024, tile, 127);

  convert_linear(p.in[2], (bf16_t*)(ws + WT_SH0), 16384, false);
  if (bid == nb - 1 && tid < 128) ((uint4*)(ws + WT_ZERO))[tid] = make_uint4(0, 0, 0, 0);
}

#define SAS 72
struct GemmA {
  const bf16_t* A; int lda;
  const float* mix; const bf16_t* sh0; const bf16_t* zero;
};

template <int MIX, int SWAP = 0>
__device__ __forceinline__ void gemm_mainloop(f32x16 (&acc)[2][2], const GemmA& ga, const bf16_t* __restrict__ Bt,
                                              int ldb, int Nvalid, int K, int m0, int n0, bf16_t* sA, bf16_t* sB) {
  const int tid = threadIdx.x, lane = tid & 63, wave = tid >> 6;
  const int wm = wave >> 1, wn = wave & 1;
  const int lrow = tid >> 3, kc = tid & 7;
#pragma unroll
  for (int i = 0; i < 2; i++)
#pragma unroll
    for (int j = 0; j < 2; j++)
#pragma unroll
      for (int r = 0; r < 16; r++) acc[i][j][r] = 0.f;
  const bf16_t* arow[4]; const bf16_t* prow[4]; const bf16_t* brow[4]; bool bval[4];
#pragma unroll
  for (int i = 0; i < 4; i++) {
    const int t = m0 + lrow + 32 * i;
    arow[i] = ga.A + (size_t)t * ga.lda + kc * 8;
    prow[i] = arow[i];
    if (MIX) {
      int b, l;
      if (t < TP) { b = t / LP; l = t - b * LP; } else { int s = t - TP; b = s >> 2; l = s & 3; }
      const bf16_t* pr = (l == 0) ? ((t < TP) ? ga.zero : (ga.sh0 + b * DM)) : (ga.A + (size_t)(t - 1) * ga.lda);
      prow[i] = pr + kc * 8;
    }
    const int n = n0 + lrow + 32 * i;
    bval[i] = n < Nvalid;
    brow[i] = Bt + (size_t)(bval[i] ? n : 0) * ldb + kc * 8;
  }
  uint4 rx0[4], rp0[4], rb0[4], rx1[4], rp1[4], rb1[4];
#define GLOAD(RX, RP, RB, k0_)                                                      \
  {                                                                                 \
    _Pragma("unroll") for (int i = 0; i < 4; i++) {                                 \
      RX[i] = *(const uint4*)(arow[i] + (k0_));                                     \
      if (MIX) RP[i] = *(const uint4*)(prow[i] + (k0_));                            \
      RB[i] = bval[i] ? *(const uint4*)(brow[i] + (k0_)) : make_uint4(0, 0, 0, 0);  \
    }                                                                               \
  }
#define GSTORE(RX, RP, RB, k0_, dA_, dB_)                                           \
  {                                                                                 \
    float4 MA, MB;                                                                  \
    if (MIX) { MA = *(const float4*)(ga.mix + (k0_) + kc * 8); MB = *(const float4*)(ga.mix + (k0_) + kc * 8 + 4); } \
    _Pragma("unroll") for (int i = 0; i < 4; i++) {                                 \
      uint4 v = RX[i];                                                              \
      if (MIX) {                                                                    \
        const uint4 x = RX[i], q = RP[i];                                           \
        float xl, xh, pl, ph;                                                       \
        xl = bflo(x.x); xh = bfhi(x.x); pl = bflo(q.x); ph = bfhi(q.x);             \
        v.x = cvtpk(xl + (pl - xl) * MA.x, xh + (ph - xh) * MA.y);                  \
        xl = bflo(x.y); xh = bfhi(x.y); pl = bflo(q.y); ph = bfhi(q.y);             \
        v.y = cvtpk(xl + (pl - xl) * MA.z, xh + (ph - xh) * MA.w);                  \
        xl = bflo(x.z); xh = bfhi(x.z); pl = bflo(q.z); ph = bfhi(q.z);             \
        v.z = cvtpk(xl + (pl - xl) * MB.x, xh + (ph - xh) * MB.y);                  \
        xl = bflo(x.w); xh = bfhi(x.w); pl = bflo(q.w); ph = bfhi(q.w);             \
        v.w = cvtpk(xl + (pl - xl) * MB.z, xh + (ph - xh) * MB.w);                  \
      }                                                                             \
      *(uint4*)((dA_) + (lrow + 32 * i) * SAS + kc * 8) = v;                        \
      *(uint4*)((dB_) + (lrow + 32 * i) * SAS + kc * 8) = RB[i];                    \
    }                                                                               \
  }
#define GCOMPUTE(cA_, cB_)                                                          \
  {                                                                                 \
    _Pragma("unroll") for (int ks = 0; ks < 4; ks++) {                              \
      bf16x8 a[2], b[2];                                                            \
      _Pragma("unroll") for (int i = 0; i < 2; i++) {                               \
        a[i] = *(const bf16x8*)((cA_) + (wm * 64 + i * 32 + (lane & 31)) * SAS + ks * 16 + (lane >> 5) * 8); \
        b[i] = *(const bf16x8*)((cB_) + (wn * 64 + i * 32 + (lane & 31)) * SAS + ks * 16 + (lane >> 5) * 8); \
      }                                                                             \
      _Pragma("unroll") for (int i = 0; i < 2; i++)                                 \
        _Pragma("unroll") for (int j = 0; j < 2; j++)                               \
          acc[i][j] = SWAP ? __builtin_amdgcn_mfma_f32_32x32x16_bf16(b[j], a[i], acc[i][j], 0, 0, 0) \
                           : __builtin_amdgcn_mfma_f32_32x32x16_bf16(a[i], b[j], acc[i][j], 0, 0, 0); \
    }                                                                               \
  }
  bf16_t* A0 = sA; bf16_t* B0 = sA + 128 * SAS;
  bf16_t* A1 = sA + 2 * 128 * SAS; bf16_t* B1 = A1 + 128 * SAS;
  const int nk = K >> 6;
  __syncthreads();
  GLOAD(rx0, rp0, rb0, 0);
  if (nk > 1) GLOAD(rx1, rp1, rb1, 64);
  GSTORE(rx0, rp0, rb0, 0, A0, B0);
  if (nk > 2) GLOAD(rx0, rp0, rb0, 128);
  __syncthreads();
  for (int t = 0; t < nk; t += 2) {
    if (t + 1 < nk) {
      GSTORE(rx1, rp1, rb1, (t + 1) * 64, A1, B1);
      if (t + 3 < nk) GLOAD(rx1, rp1, rb1, (t + 3) * 64);
    }
    GCOMPUTE(A0, B0);
    __syncthreads();
    if (t + 1 < nk) {
      if (t + 2 < nk) {
        GSTORE(rx0, rp0, rb0, (t + 2) * 64, A0, B0);
        if (t + 4 < nk) GLOAD(rx0, rp0, rb0, (t + 4) * 64);
      }
      GCOMPUTE(A1, B1);
      __syncthreads();
    }
  }
#undef GLOAD
#undef GSTORE
#undef GCOMPUTE
}

template <class F>
__device__ __forceinline__ void gemm_epilogue(const f32x16 (&acc)[2][2], int m0, int n0, F f) {
  const int tid = threadIdx.x, lane = tid & 63, wave = tid >> 6;
  const int wm = wave >> 1, wn = wave & 1;
#pragma unroll
  for (int i = 0; i < 2; i++)
#pragma unroll
    for (int j = 0; j < 2; j++)
#pragma unroll
      for (int r = 0; r < 16; r++) {
        const int row = m0 + wm * 64 + i * 32 + (lane >> 5) * 4 + (r & 3) + 8 * (r >> 2);
        const int col = n0 + wn * 64 + j * 32 + (lane & 31);
        f(row, col, acc[i][j][r]);
      }
}

template <class F>
__device__ __forceinline__ void gemm_epilogue_bf16_lds(const f32x16 (&acc)[2][2], bf16_t* __restrict__ out, size_t ld, int m0, int c0,
                                                       int ctile0, bf16_t* T, F f) {
  const int tid = threadIdx.x, lane = tid & 63, wave = tid >> 6;
  const int wm = wave >> 1, wn = wave & 1;
#pragma unroll
  for (int i = 0; i < 2; i++)
#pragma unroll
    for (int j = 0; j < 2; j++)
#pragma unroll
      for (int q = 0; q < 4; q++) {
        const int rowl = wm * 64 + i * 32 + (lane & 31);
        const int coll = wn * 64 + j * 32 + (lane >> 5) * 4 + 8 * q;
        const int cg = ctile0 + coll;
        *(uint2*)(T + rowl * 136 + coll) = make_uint2(cvtpk(f(cg, acc[i][j][4 * q]), f(cg + 1, acc[i][j][4 * q + 1])),
                                                      cvtpk(f(cg + 2, acc[i][j][4 * q + 2]), f(cg + 3, acc[i][j][4 * q + 3])));
      }
  __syncthreads();
#pragma unroll
  for (int k = 0; k < 8; k++) {
    const int c = tid + 256 * k;
    const int row = c >> 4, ch = c & 15;
    *(uint4*)(out + (size_t)(m0 + row) * ld + c0 + ch * 8) = *(const uint4*)(T + row * 136 + ch * 8);
  }
}

__device__ __forceinline__ bool xcd_tile(int k, int MT, int NT, int& tm, int& col) {
  const int nb = gridDim.x, bid = blockIdx.x;
  const int total = MT * NT;
  if ((nb & 7) != 0 || (MT & 7) == 0) {
    const int idx = bid + k * nb;
    if (idx >= total) return false;
    tm = idx / NT; col = idx - tm * NT;
    return true;
  }
  const int x = bid & 7, li = bid >> 3, nloc = nb >> 3;
  const int s0 = (int)(((long long)total * x) >> 3), s1 = (int)(((long long)total * (x + 1)) >> 3);
  const int idx = s0 + li + k * nloc;
  if (idx >= s1) return false;
  const int G = MT >> 3, R = MT & 7;
  const int full = G * 8 * NT;
  if (idx < full) { const int tg = idx / (8 * NT); const int rem = idx - tg * 8 * NT; col = rem >> 3; tm = tg * 8 + (rem & 7); }
  else { const int i2 = idx - full; col = i2 / R; tm = G * 8 + (i2 - col * R); }
  return true;
}

__device__ __forceinline__ void phase_rwkv_proj(const Params& p, char* smem) {
  bf16_t* sA = (bf16_t*)smem; bf16_t* sB = sA + 128 * SAS;
  char* ws = p.ws;
  int tile = blockIdx.x;
  for (; tile < 133 * 4; tile += gridDim.x) {
    const int tm = tile >> 2, jt = tile & 3;
    const int job = (jt == 0) ? 3 : (jt == 1) ? 4 : 5;
    const int tn = (jt == 3) ? 1 : 0;
    const int mixidx = (job == 3) ? 1 : (job == 4) ? 4 : 5;
    GemmA ga;
    ga.A = (const bf16_t*)(ws + OFF_XN); ga.lda = DM;
    ga.mix = p.in[10] + mixidx * DM;
    ga.sh0 = (const bf16_t*)(ws + WT_SH0); ga.zero = (const bf16_t*)(ws + WT_ZERO);
    const bf16_t* Bt; int Nv;
    if (job == 3) { Bt = (const bf16_t*)(ws + WT_W1); Nv = 64; }
    else if (job == 4) { Bt = (const bf16_t*)(ws + WT_A1); Nv = 64; }
    else { Bt = (const bf16_t*)(ws + WT_G1); Nv = 192; }
    f32x16 acc[2][2];
    gemm_mainloop<1>(acc, ga, Bt, 1024, Nv, 1024, tm * 128, tn * 128, sA, sB);
    if (job == 3) {
      bf16_t* o = (bf16_t*)(ws + OFF_L1W);
      gemm_epilogue(acc, tm * 128, 0, [&](int row, int col, float v) { if (col < 64) o[(size_t)row * 64 + col] = f2bf(tanhf(v)); });
    } else if (job == 4) {
      bf16_t* o = (bf16_t*)(ws + OFF_L1A);
      gemm_epilogue(acc, tm * 128, 0, [&](int row, int col, float v) { if (col < 64) o[(size_t)row * 64 + col] = f2bf(v); });
    } else {
      bf16_t* o = (bf16_t*)(ws + OFF_L1G);
      gemm_epilogue(acc, tm * 128, tn * 128, [&](int row, int col, float v) { if (col < 192) o[(size_t)row * 192 + col] = f2bf(sigmoidf_(v)); });
    }
  }
  for (; tile < 133 * 28; tile += gridDim.x) {
    const int t2 = tile - 133 * 4;
    const int tm = t2 / 24, jt = t2 - tm * 24;
    const int job = jt >> 3, tn = jt & 7;
    const int mixidx = (job == 0) ? 0 : (job == 1) ? 2 : 3;
    GemmA ga;
    ga.A = (const bf16_t*)(ws + OFF_XN); ga.lda = DM;
    ga.mix = p.in[10] + mixidx * DM;
    ga.sh0 = (const bf16_t*)(ws + WT_SH0); ga.zero = (const bf16_t*)(ws + WT_ZERO);
    const bf16_t* Bt = (const bf16_t*)(ws + WT_RKV) + (size_t)job * 1048576;
    f32x16 acc[2][2];
    gemm_mainloop<1, 1>(acc, ga, Bt, 1024, 1024, 1024, tm * 128, tn * 128, sA, sB);
    bf16_t* o = (bf16_t*)(ws + (job == 0 ? OFF_R : job == 1 ? OFF_K : OFF_V));
    gemm_epilogue_bf16_lds(acc, o, DM, tm * 128, tn * 128, tn * 128, sA, [&](int, float v) { return v; });
  }
}

__device__ __forceinline__ void phase_rwkv_lora2(const Params& p, char* smem) {
  bf16_t* sA = (bf16_t*)smem; bf16_t* sB = sA + 128 * SAS;
  char* ws = p.ws;
  for (int kk_ = 0;; kk_++) {
    int tm, jt;
    if (!xcd_tile(kk_, 133, 24, tm, jt)) break;
    const int job = jt >> 3, tn = jt & 7;
    GemmA ga; ga.mix = nullptr; ga.sh0 = nullptr; ga.zero = nullptr;
    const bf16_t* Bt; int K;
    if (job == 0) { ga.A = (const bf16_t*)(ws + OFF_L1W); ga.lda = 64; Bt = (const bf16_t*)(ws + WT_W2); K = 64; }
    else if (job == 1) { ga.A = (const bf16_t*)(ws + OFF_L1A); ga.lda = 64; Bt = (const bf16_t*)(ws + WT_A2); K = 64; }
    else { ga.A = (const bf16_t*)(ws + OFF_L1G); ga.lda = 192; Bt = (const bf16_t*)(ws + WT_G2); K = 192; }
    f32x16 acc[2][2];
    if (job == 1) {
      gemm_mainloop<0, 1>(acc, ga, Bt, K, 1024, K, tm * 128, tn * 128, sA, sB);
      const float* a0 = p.in[15];
      gemm_epilogue_bf16_lds(acc, (bf16_t*)(ws + OFF_A), DM, tm * 128, tn * 128, tn * 128, sA, [&](int col, float v) { return sigmoidf_(a0[col] + v); });
      continue;
    }
    if (job == 2) {
      gemm_mainloop<0, 1>(acc, ga, Bt, K, 1024, K, tm * 128, tn * 128, sA, sB);
      gemm_epilogue_bf16_lds(acc, (bf16_t*)(ws + OFF_G), DM, tm * 128, tn * 128, tn * 128, sA, [&](int, float v) { return v; });
      continue;
    }
    gemm_mainloop<0>(acc, ga, Bt, K, 1024, K, tm * 128, tn * 128, sA, sB);
    if (job == 0) {
      float* o = (float*)(ws + OFF_DEC); const float* w0 = p.in[12];
      gemm_epilogue(acc, tm * 128, tn * 128, [&](int row, int col, float v) {
        const float wl = -softplusf_(-(w0[col] + v)) - 0.5f;
        o[(size_t)row * DM + col] = -__expf(wl);
      });
    } else if (job == 1) {
      bf16_t* o = (bf16_t*)(ws + OFF_A); const float* a0 = p.in[15];
      gemm_epilogue(acc, tm * 128, tn * 128, [&](int row, int col, float v) { o[(size_t)row * DM + col] = f2bf(sigmoidf_(a0[col] + v)); });
    } else {
      bf16_t* o = (bf16_t*)(ws + OFF_G);
      gemm_epilogue(acc, tm * 128, tn * 128, [&](int row, int col, float v) { o[(size_t)row * DM + col] = f2bf(v); });
    }
  }
}

typedef float f32x4v __attribute__((ext_vector_type(4)));
struct RBlk { bf16_t* base; int stride; };
__device__ __forceinline__ RBlk rwkv_blk(char* ws, size_t arr_off, int which, bool prompt, size_t tok0, int h, int sidx) {
  RBlk r;
  if (prompt) {
    if (which == 4) { r.base = (bf16_t*)(ws + OFF_DEC) + tok0 * 2048 + h * 128; r.stride = 2048; }
    else { r.base = (bf16_t*)(ws + arr_off) + tok0 * DM + h * 64; r.stride = DM; }
  }
  else { r.base = (bf16_t*)(ws + OFF_RSP) + ((size_t)sidx * 5 + which) * 1024; r.stride = 64; }
  return r;
}
__device__ __forceinline__ void phase_rwkv_prep(const Params& p, char* smem) {
  const int lane = threadIdx.x & 63, wave = threadIdx.x >> 6;
  char* ws = p.ws;
  char* wsm = smem + wave * 17856;
  bf16_t* sQR = (bf16_t*)wsm;
  bf16_t* sBK = sQR + 32 * 72;
  float* sC = (float*)(sBK + 32 * 72);
  bf16_t* sV = (bf16_t*)(sC + 32 * 33);
  float* sX = (float*)(sV + 16 * 72);
  const bf16_t* Rb = (const bf16_t*)(ws + OFF_R); const bf16_t* Kb = (const bf16_t*)(ws + OFF_K);
  const bf16_t* Vb = (const bf16_t*)(ws + OFF_V); const bf16_t* Ab = (const bf16_t*)(ws + OFF_A);
  const float* LWb = (const float*)(ws + OFF_DEC);
  float* BON = (float*)(ws + OFF_BON);
  const int c16 = lane & 15, g = lane >> 4;
  for (int it = blockIdx.x * 4 + wave; it < 18560; it += gridDim.x * 4) {
    const bool prompt = it < 16512;
    int h, nvalid, sidx = 0; size_t tok0;
    if (prompt) { h = it & 15; const int q = it >> 4; const int b = q / 129, ch = q - b * 129; tok0 = (size_t)b * LP + ch * 16; nvalid = 16; }
    else { sidx = it - 16512; h = sidx & 15; tok0 = TP + (size_t)(sidx >> 4) * 4; nvalid = 4; }
    const int col = h * 64 + lane;
    const float kkc = p.in[20][col], kac = p.in[21][col], rkc = p.in[22][col];
    float rr[16], kr[16], vr[16], ar[16], lw[16];
#pragma unroll
    for (int tt = 0; tt < 16; tt++) {
      if (tt < nvalid) {
        const size_t off = (tok0 + tt) * DM + col;
        rr[tt] = bf2f(Rb[off]); kr[tt] = bf2f(Kb[off]); vr[tt] = bf2f(Vb[off]); ar[tt] = bf2f(Ab[off]); lw[tt] = LWb[off];
      } else { rr[tt] = 0.f; kr[tt] = 0.f; vr[tt] = 0.f; ar[tt] = 0.f; lw[tt] = 0.f; }
    }
    float bi[16], ki[16];
    float cum = 0.f;
#pragma unroll
    for (int tt = 0; tt < 16; tt++) {
      float kk = kr[tt] * kkc;
      const float n2 = wave_sum(kk * kk);
      kk = kk / fmaxf(sqrtf(n2), 1e-12f);
      const float kp = kr[tt] * (1.f + (ar[tt] - 1.f) * kac);
      const float bb = kk * ar[tt];
      const float bon = wave_sum(rr[tt] * kp * rkc);
      if (tt < nvalid && lane == 0) BON[(tok0 + tt) * 16 + h] = bon;
      const float eprev = __expf(cum);
      cum += lw[tt];
      const float ecur = __expf(cum), einv = __expf(-cum);
      bi[tt] = bb * einv; ki[tt] = kp * einv;
      sQR[tt * 72 + lane] = f2bf(kk * eprev);
      sQR[(16 + tt) * 72 + lane] = f2bf(rr[tt] * ecur);
      sBK[tt * 72 + lane] = f2bf(bi[tt]);
      sBK[(16 + tt) * 72 + lane] = f2bf(ki[tt]);
      sV[tt * 72 + lane] = f2bf(vr[tt]);
    }
    const float eQ = __expf(cum);
    char* small = ws + OFF_RSM + (size_t)it * RSM_ITEM;
    ((float*)(small + 2048))[lane] = eQ;
    asm volatile("s_waitcnt lgkmcnt(0)" ::: "memory");
    __builtin_amdgcn_wave_barrier();
    {
      f32x16 acc;
#pragma unroll
      for (int r = 0; r < 16; r++) acc[r] = 0.f;
#pragma unroll
      for (int ks = 0; ks < 4; ks++) {
        const bf16x8 af = *(const bf16x8*)(sQR + (lane & 31) * 72 + ks * 16 + (lane >> 5) * 8);
        const bf16x8 bf = *(const bf16x8*)(sBK + (lane & 31) * 72 + ks * 16 + (lane >> 5) * 8);
        acc = __builtin_amdgcn_mfma_f32_32x32x16_bf16(af, bf, acc, 0, 0, 0);
      }
#pragma unroll
      for (int r = 0; r < 16; r++) sC[((lane >> 5) * 4 + (r & 3) + 8 * (r >> 2)) * 33 + (lane & 31)] = acc[r];
    }
    asm volatile("s_waitcnt lgkmcnt(0)" ::: "memory");
    __builtin_amdgcn_wave_barrier();
#pragma unroll
    for (int tt = 0; tt < 16; tt++) {
      sBK[tt * 72 + lane] = f2bf(bi[tt] * eQ);
      sBK[(16 + tt) * 72 + lane] = f2bf(ki[tt] * eQ);
    }
    {
      const int c = lane & 31;
      float xr[16];
#pragma unroll
      for (int t = 0; t < 16; t++) {
        float acc;
        if (c < 16) acc = (c == t) ? 1.f : 0.f;
        else acc = ((c - 16) < t) ? sC[t * 33 + c] : 0.f;
#pragma unroll
        for (int i = 0; i < 16; i++) if (i < t) acc -= sC[t * 33 + i] * xr[i];
        xr[t] = acc;
      }
      if (lane < 32) {
#pragma unroll
        for (int t = 0; t < 16; t++) sX[t * 33 + c] = -xr[t];
      }
    }
    asm volatile("s_waitcnt lgkmcnt(0)" ::: "memory");
    __builtin_amdgcn_wave_barrier();
    {
      float f[8];
#pragma unroll
      for (int jj = 0; jj < 4; jj++) { f[jj] = sX[c16 * 33 + 4 * g + jj]; f[4 + jj] = sX[c16 * 33 + 16 + 4 * g + jj]; }
      ((uint4*)small)[lane] = pack8(f);
#pragma unroll
      for (int jj = 0; jj < 4; jj++) {
        const int i = 4 * g + jj;
        f[jj] = (i <= c16) ? sC[(16 + c16) * 33 + i] : 0.f;
        f[4 + jj] = (i <= c16) ? sC[(16 + c16) * 33 + 16 + i] : 0.f;
      }
      ((uint4*)(small + 1024))[lane] = pack8(f);
    }
    {
      const RBlk bq = rwkv_blk(ws, OFF_R, 0, prompt, tok0, h, sidx), br = rwkv_blk(ws, OFF_K, 1, prompt, tok0, h, sidx);
#pragma unroll
      for (int m = 0; m < 2; m++) {
        const int idx = m * 64 + lane;
        const int k0 = 32 * m + 4 * g;
        const uint2 q0 = *(const uint2*)(sQR + c16 * 72 + k0), q1 = *(const uint2*)(sQR + c16 * 72 + k0 + 16);
        *(uint4*)(bq.base + (size_t)(idx >> 3) * bq.stride + (idx & 7) * 8) = make_uint4(q0.x, q0.y, q1.x, q1.y);
        const uint2 r0 = *(const uint2*)(sQR + (16 + c16) * 72 + k0), r1 = *(const uint2*)(sQR + (16 + c16) * 72 + k0 + 16);
        *(uint4*)(br.base + (size_t)(idx >> 3) * br.stride + (idx & 7) * 8) = make_uint4(r0.x, r0.y, r1.x, r1.y);
      }
    }
    {
      const RBlk b0 = rwkv_blk(ws, OFF_A, 2, prompt, tok0, h, sidx), b1 = rwkv_blk(ws, OFF_BB, 3, prompt, tok0, h, sidx);
#pragma unroll
      for (int kb = 0; kb < 4; kb++) {
        const int k = 16 * kb + c16;
        unsigned w[4];
#pragma unroll
        for (int e = 0; e < 2; e++) {
          w[e] = (unsigned)sBK[(4 * g + 2 * e) * 72 + k] | ((unsigned)sBK[(4 * g + 2 * e + 1) * 72 + k] << 16);
          w[2 + e] = (unsigned)sBK[(16 + 4 * g + 2 * e) * 72 + k] | ((unsigned)sBK[(16 + 4 * g + 2 * e + 1) * 72 + k] << 16);
        }
        const RBlk& bk = (kb < 2) ? b0 : b1;
        const int idx = (kb & 1) * 64 + lane;
        *(uint4*)(bk.base + (size_t)(idx >> 3) * bk.stride + (idx & 7) * 8) = make_uint4(w[0], w[1], w[2], w[3]);
      }
    }
    {
      const RBlk bv = rwkv_blk(ws, OFF_V, 4, prompt, tok0, h, sidx);
#pragma unroll
      for (int vq = 0; vq < 4; vq++) {
        const int v = vq * 16 + c16;
        const unsigned w0 = (unsigned)sV[(4 * g) * 72 + v] | ((unsigned)sV[(4 * g + 1) * 72 + v] << 16);
        const unsigned w1 = (unsigned)sV[(4 * g + 2) * 72 + v] | ((unsigned)sV[(4 * g + 3) * 72 + v] << 16);
        const int idx = vq * 64 + lane;
        *(uint2*)(bv.base + (size_t)(idx >> 4) * bv.stride + (idx & 15) * 4) = make_uint2(w0, w1);
      }
    }
    asm volatile("s_waitcnt lgkmcnt(0)" ::: "memory");
    __builtin_amdgcn_wave_barrier();
  }
}

struct RPf { uint4 a, b, c, d; };
__device__ __forceinline__ bf16x8 pk8(float a0, float a1, float a2, float a3, unsigned w2, unsigned w3) {
  return __builtin_bit_cast(bf16x8, make_uint4(cvtpk(a0, a1), cvtpk(a2, a3), w2, w3));
}
__device__ __forceinline__ void rwkv_scan_block(const Params& p, int hitem, char* smem) {
  const int tid = threadIdx.x, lane = tid & 63, vq = tid >> 6;
  const int c16 = lane & 15, g = lane >> 4;
  char* ws = p.ws;
  const bool prompt = hitem < 128;
  int h, nch, nvalid, sidx = 0, b; size_t tokb; const float* S0; float* Sout;
  if (prompt) { b = hitem >> 4; h = hitem & 15; nch = 129; nvalid = 16; tokb = (size_t)b * LP; S0 = nullptr; Sout = p.out + OUT3 + (size_t)hitem * 4096; }
  else { sidx = hitem - 128; b = sidx >> 4; h = sidx & 15; nch = 1; nvalid = 4; tokb = TP + (size_t)b * 4; S0 = p.in[3] + (size_t)sidx * 4096; Sout = p.out + OUT7 + (size_t)sidx * 4096; }
  f32x4v st[4];
#pragma unroll
  for (int kb = 0; kb < 4; kb++) {
    if (S0) { const float4 v = *(const float4*)(S0 + (vq * 16 + c16) * 64 + 16 * kb + 4 * g); st[kb] = f32x4v{v.x, v.y, v.z, v.w}; }
    else st[kb] = f32x4v{0.f, 0.f, 0.f, 0.f};
  }
  bf16_t* Ob = (bf16_t*)(ws + OFF_Y);
  const char *pa, *pb, *pc, *pd; size_t sta, stc, stv;
  {
    const size_t tok0 = tokb;
    const int it0 = prompt ? ((b * 129) * 16 + h) : (16512 + sidx);
    const int idx = tid & 127;
    const RBlk Ba = (tid < 128) ? rwkv_blk(ws, OFF_R, 0, prompt, tok0, h, sidx) : rwkv_blk(ws, OFF_K, 1, prompt, tok0, h, sidx);
    pa = (const char*)(Ba.base + (size_t)(idx >> 3) * Ba.stride + (idx & 7) * 8);
    const RBlk Bb = (tid < 128) ? rwkv_blk(ws, OFF_A, 2, prompt, tok0, h, sidx) : rwkv_blk(ws, OFF_BB, 3, prompt, tok0, h, sidx);
    pb = (const char*)(Bb.base + (size_t)(idx >> 3) * Bb.stride + (idx & 7) * 8);
    const char* small = ws + OFF_RSM + (size_t)it0 * RSM_ITEM;
    if (tid < 128) pc = small + tid * 16;
    else {
      const RBlk Bv = rwkv_blk(ws, OFF_V, 4, prompt, tok0, h, sidx);
      const int i2 = 2 * (tid - 128);
      pc = (const char*)(Bv.base + (size_t)(i2 >> 4) * Bv.stride + (i2 & 15) * 4);
    }
    pd = small + 2048 + (tid & 15) * 16;
    sta = (size_t)16 * DM * 2;
    stc = (size_t)16 * RSM_ITEM;
    stv = (tid < 128) ? stc : (size_t)16 * 2048 * 2;
  }
  auto issue = [&](uint4& fa, uint4& fb, uint4& fc, uint4& fd, int ch) __attribute__((always_inline)) {
    fa = *(const uint4*)(pa + (size_t)ch * sta);
    fb = *(const uint4*)(pb + (size_t)ch * sta);
    fc = *(const uint4*)(pc + (size_t)ch * stv);
    fd = *(const uint4*)(pd + (size_t)ch * stc);
  };
  auto body = [&](uint4& fa, uint4& fb, uint4& fc, uint4& fd, int ch) __attribute__((always_inline)) {
    uint4* slot = (uint4*)(smem + (ch & 1) * 12544);
    slot[tid] = fa; slot[256 + tid] = fb; slot[512 + tid] = fc;
    if (tid < 16) slot[768 + tid] = fd;
    if (ch + 8 < nch) issue(fa, fb, fc, fd, ch + 8);
    __syncthreads();
    const uint4 kq0 = slot[lane], kq1 = slot[64 + lane], rq0 = slot[128 + lane], rq1 = slot[192 + lane];
    const uint4 se0 = slot[256 + lane], se1 = slot[320 + lane], se2 = slot[384 + lane], se3 = slot[448 + lane];
    const uint4 tu = slot[512 + lane], ao = slot[576 + lane];
    const uint2 vb = ((const uint2*)(slot + 640))[vq * 64 + lane];
    const float4* pqp = (const float4*)(slot + 768);
    const f32x4v z4 = f32x4v{0.f, 0.f, 0.f, 0.f};
    const bf16x8 bs0 = __builtin_bit_cast(bf16x8, make_uint4(cvtpk(st[0][0], st[0][1]), cvtpk(st[0][2], st[0][3]), cvtpk(st[1][0], st[1][1]), cvtpk(st[1][2], st[1][3])));
    const bf16x8 bs1 = __builtin_bit_cast(bf16x8, make_uint4(cvtpk(st[2][0], st[2][1]), cvtpk(st[2][2], st[2][3]), cvtpk(st[3][0], st[3][1]), cvtpk(st[3][2], st[3][3])));
    f32x4v w1 = __builtin_amdgcn_mfma_f32_16x16x32_bf16(__builtin_bit_cast(bf16x8, kq0), bs0, z4, 0, 0, 0);
    w1 = __builtin_amdgcn_mfma_f32_16x16x32_bf16(__builtin_bit_cast(bf16x8, kq1), bs1, w1, 0, 0, 0);
    f32x4v w3 = __builtin_amdgcn_mfma_f32_16x16x32_bf16(__builtin_bit_cast(bf16x8, rq0), bs0, z4, 0, 0, 0);
    w3 = __builtin_amdgcn_mfma_f32_16x16x32_bf16(__builtin_bit_cast(bf16x8, rq1), bs1, w3, 0, 0, 0);
    const bf16x8 bu = pk8(w1[0], w1[1], w1[2], w1[3], vb.x, vb.y);
    const f32x4v u = __builtin_amdgcn_mfma_f32_16x16x32_bf16(__builtin_bit_cast(bf16x8, tu), bu, z4, 0, 0, 0);
    const bf16x8 bo = pk8(u[0], u[1], u[2], u[3], vb.x, vb.y);
    const f32x4v o = __builtin_amdgcn_mfma_f32_16x16x32_bf16(__builtin_bit_cast(bf16x8, ao), bo, w3, 0, 0, 0);
    {
      const float4 q0 = pqp[g], q1 = pqp[4 + g], q2 = pqp[8 + g], q3 = pqp[12 + g];
      st[0] = __builtin_amdgcn_mfma_f32_16x16x32_bf16(__builtin_bit_cast(bf16x8, se0), bo, st[0] * f32x4v{q0.x, q0.y, q0.z, q0.w}, 0, 0, 0);
      st[1] = __builtin_amdgcn_mfma_f32_16x16x32_bf16(__builtin_bit_cast(bf16x8, se1), bo, st[1] * f32x4v{q1.x, q1.y, q1.z, q1.w}, 0, 0, 0);
      st[2] = __builtin_amdgcn_mfma_f32_16x16x32_bf16(__builtin_bit_cast(bf16x8, se2), bo, st[2] * f32x4v{q2.x, q2.y, q2.z, q2.w}, 0, 0, 0);
      st[3] = __builtin_amdgcn_mfma_f32_16x16x32_bf16(__builtin_bit_cast(bf16x8, se3), bo, st[3] * f32x4v{q3.x, q3.y, q3.z, q3.w}, 0, 0, 0);
    }
#pragma unroll
    for (int j = 0; j < 4; j++) {
      const int t = 4 * g + j;
      if (t < nvalid) Ob[(tokb + (size_t)ch * 16 + t) * DM + h * 64 + vq * 16 + c16] = f2bf(o[j]);
    }
  };
  uint4 a0, b0, c0, d0, a1, b1, c1, d1, a2, b2, c2, d2, a3, b3, c3, d3, a4, b4, c4, d4, a5, b5, c5, d5, a6, b6, c6, d6, a7, b7, c7, d7;
  issue(a0, b0, c0, d0, 0);
  if (1 < nch) issue(a1, b1, c1, d1, 1);
  if (2 < nch) issue(a2, b2, c2, d2, 2);
  if (3 < nch) issue(a3, b3, c3, d3, 3);
  if (4 < nch) issue(a4, b4, c4, d4, 4);
  if (5 < nch) issue(a5, b5, c5, d5, 5);
  if (6 < nch) issue(a6, b6, c6, d6, 6);
  if (7 < nch) issue(a7, b7, c7, d7, 7);
  for (int cc = 0; cc < nch; cc += 8) {
    body(a0, b0, c0, d0, cc);
    if (cc + 1 < nch) body(a1, b1, c1, d1, cc + 1);
    if (cc + 2 < nch) body(a2, b2, c2, d2, cc + 2);
    if (cc + 3 < nch) body(a3, b3, c3, d3, cc + 3);
    if (cc + 4 < nch) body(a4, b4, c4, d4, cc + 4);
    if (cc + 5 < nch) body(a5, b5, c5, d5, cc + 5);
    if (cc + 6 < nch) body(a6, b6, c6, d6, cc + 6);
    if (cc + 7 < nch) body(a7, b7, c7, d7, cc + 7);
  }
#pragma unroll
  for (int kb = 0; kb < 4; kb++)
    *(float4*)(Sout + (vq * 16 + c16) * 64 + 16 * kb + 4 * g) = make_float4(st[kb][0], st[kb][1], st[kb][2], st[kb][3]);
  __syncthreads();
}

__device__ __forceinline__ void late_transposes(const Params& p, char* smem, int vb, int vnb) {
  float* tile = (float*)smem;
  char* ws = p.ws;
  __syncthreads();
  transpose_job(p.in[25], 1024, 1024, (bf16_t*)(ws + WT_WO), 1024, 1024, tile, 175, vb, vnb);
  transpose_job(p.in[34], 1024, 2048, (bf16_t*)(ws + WT_Q), 1024, 2048, tile, 128, vb, vnb);
  convert_linear(p.in[35], (bf16_t*)(ws + WT_SK), 65536, false, vb, vnb);
  transpose_job(p.in[26], 1024, 5152, (bf16_t*)(ws + WT_IN), 1024, 5152, tile, 0, vb, vnb);
  transpose_job(p.in[33], 2048, 1024, (bf16_t*)(ws + WT_OUT), 2048, 1024, tile, 64, vb, vnb);
  transpose_job(p.in[34] + 2097152, 1024, 2048, (bf16_t*)(ws + WT_Q) + 2097152, 1024, 2048, tile, 192, vb, vnb);
}

__device__ __forceinline__ void phase_rwkv_scan(const Params& p, char* smem) {
  const int nb = gridDim.x, bid = blockIdx.x;
  if (nb > 192) {
    if (bid < 128) rwkv_scan_block(p, bid, smem);
    else {
      for (int it = bid - 128; it < 2048; it += nb - 128) rwkv_scan_block(p, 128 + it, smem);
      convert_tables_fp8(p, bid - 128, nb - 128, 0);
      late_transposes(p, smem, bid - 128, nb - 128);
    }
  } else {
    for (int it = bid; it < 128 + 2048; it += nb) rwkv_scan_block(p, it, smem);
    convert_tables_fp8(p, bid, nb, 0);
    late_transposes(p, smem, bid, nb);
  }
}

__device__ __forceinline__ void phase_rwkv_out(const Params& p) {
  const int lane = threadIdx.x & 63, wave = threadIdx.x >> 6;
  char* ws = p.ws;
  bf16_t* Yb = (bf16_t*)(ws + OFF_Y);
  const bf16_t* Vb = (const bf16_t*)(ws + OFF_V); const bf16_t* Gb = (const bf16_t*)(ws + OFF_G);
  const float* BON = (const float*)(ws + OFF_BON);
  for (int it = blockIdx.x * 4 + wave; it < TT * 2; it += gridDim.x * 4) {
    const int col = (it & 1) * 512 + lane * 8;
    const size_t off = (size_t)(it >> 1) * DM + col;
    float o[8], v[8], g[8], y[8];
    unpack8(*(const uint4*)(Yb + off), o); unpack8(*(const uint4*)(Vb + off), v); unpack8(*(const uint4*)(Gb + off), g);
    const float bon = BON[(size_t)(it >> 1) * 16 + (it & 1) * 8 + (lane >> 3)];
    const float4 w0 = *(const float4*)(p.in[23] + col), w1 = *(const float4*)(p.in[23] + col + 4);
    const float4 b0 = *(const float4*)(p.in[24] + col), b1 = *(const float4*)(p.in[24] + col + 4);
    const float lw[8] = {w0.x, w0.y, w0.z, w0.w, w1.x, w1.y, w1.z, w1.w};
    const float lb[8] = {b0.x, b0.y, b0.z, b0.w, b1.x, b1.y, b1.z, b1.w};
    float sm = 0.f;
#pragma unroll
    for (int e = 0; e < 8; e++) sm += o[e];
    const float mu = oct_sum(sm) * (1.f / 64.f);
    float sv = 0.f;
#pragma unroll
    for (int e = 0; e < 8; e++) { o[e] -= mu; sv += o[e] * o[e]; }
    const float rs = rsqrtf(oct_sum(sv) * (1.f / 64.f) + 64e-5f);
#pragma unroll
    for (int e = 0; e < 8; e++) y[e] = (o[e] * rs * lw[e] + lb[e] + bon * v[e]) * g[e];
    *(uint4*)(Yb + off) = pack8(y);
  }
}

__device__ __forceinline__ void phase_gemm_hadd(const Params& p, char* smem, const bf16_t* A, int lda, const bf16_t* Bt, int K, bool dry = false) {
  bf16_t* sA = (bf16_t*)smem; bf16_t* sB = sA + 128 * SAS;
  float* H = (float*)(p.ws + OFF_H);
  for (int kk_ = 0;; kk_++) {
    int tm, tn;
    if (!xcd_tile(kk_, 133, 8, tm, tn)) break;
    GemmA ga; ga.A = A; ga.lda = lda; ga.mix = nullptr; ga.sh0 = nullptr; ga.zero = nullptr;
    f32x16 acc[2][2];
    gemm_mainloop<0>(acc, ga, Bt, K, 1024, K, tm * 128, tn * 128, sA, sB);
    gemm_epilogue(acc, tm * 128, tn * 128, [&](int row, int col, float v) { if (!dry || v == 1.2345e30f) H[(size_t)row * DM + col] += v; });
  }
}

__device__ __forceinline__ void phase_peer_norm(const Params& p, int layer) {
  const int tid = threadIdx.x, lane = tid & 63, wave = tid >> 6;
  const float* H = (const float*)(p.ws + OFF_H);
  bf16_t* XN2 = (bf16_t*)(p.ws + (layer ? OFF_XN2_1 : OFF_XN2_0));
  const float4* g = (const float4*)(p.in[8] + layer * DM);
  for (int t = blockIdx.x * 4 + wave; t < TT; t += gridDim.x * 4) {
    float4 v[4]; float ss = 0.f;
#pragma unroll
    for (int i = 0; i < 4; i++) {
      v[i] = ((const float4*)(H + (size_t)t * DM))[i * 64 + lane];
      ss += v[i].x * v[i].x + v[i].y * v[i].y + v[i].z * v[i].z + v[i].w * v[i].w;
    }
    ss = wave_sum(ss);
    const float rstd = rsqrtf(ss * (1.f / 1024.f) + 1e-5f);
#pragma unroll
    for (int i = 0; i < 4; i++) {
      const float4 gg = g[i * 64 + lane];
      ((uint2*)(XN2 + (size_t)t * DM))[i * 64 + lane] =
          make_uint2(cvtpk(v[i].x * rstd * gg.x, v[i].y * rstd * gg.y), cvtpk(v[i].z * rstd * gg.z, v[i].w * rstd * gg.w));
    }
  }
}

__device__ __forceinline__ void phase_peer_query(const Params& p, int layer, char* smem) {
  const int tid = threadIdx.x, lane = tid & 63, wave = tid >> 6;
  const int wm = wave >> 1, wn = wave & 1;
  bf16_t* sA = (bf16_t*)smem; bf16_t* sB = sA + 128 * SAS;
  bf16_t* Qs = (bf16_t*)smem; bf16_t* Ks = Qs + 128 * 136;
  float* Ss = (float*)smem;
  char* ws = p.ws;
  const bf16_t* XN2 = (const bf16_t*)(ws + (layer ? OFF_XN2_1 : OFF_XN2_0));
  int* KEYS = (int*)(ws + (layer ? OFF_KEYS_1 : OFF_KEYS_0));
  const bf16_t* Bt = (const bf16_t*)(ws + WT_Q) + (size_t)layer * 2097152;
  for (int kk_ = 0;; kk_++) {
    int tm, tn;
    if (!xcd_tile(kk_, 133, 16, tm, tn)) break;
    GemmA ga; ga.A = XN2; ga.lda = DM; ga.mix = nullptr; ga.sh0 = nullptr; ga.zero = nullptr;
    f32x16 acc[2][2];
    gemm_mainloop<0>(acc, ga, Bt, 1024, 2048, 1024, tm * 128, tn * 128, sA, sB);
    __syncthreads();
#pragma unroll
    for (int i = 0; i < 2; i++)
#pragma unroll
      for (int j = 0; j < 2; j++)
#pragma unroll
        for (int r = 0; r < 16; r++) {
          const int rowl = wm * 64 + i * 32 + (lane >> 5) * 4 + (r & 3) + 8 * (r >> 2);
          const int coll = wn * 64 + j * 32 + (lane & 31);
          Qs[rowl * 136 + coll] = f2bf(acc[i][j][r]);
        }
    {
      const int hh = tn >> 1, z = tn & 1;
      const bf16_t* kp = (const bf16_t*)(ws + WT_SK) + ((size_t)((layer * 2 + z) * 8 + hh)) * 16384;
#pragma unroll
      for (int c = tid; c < 2048; c += 256) {
        const int key = c >> 4, dc = c & 15;
        *(uint4*)(Ks + key * 136 + dc * 8) = *(const uint4*)(kp + key * 128 + dc * 8);
      }
    }
    __syncthreads();
#pragma unroll
    for (int i = 0; i < 2; i++)
#pragma unroll
      for (int j = 0; j < 2; j++)
#pragma unroll
        for (int r = 0; r < 16; r++) acc[i][j][r] = 0.f;
#pragma unroll
    for (int ks = 0; ks < 8; ks++) {
      bf16x8 a[2], b[2];
#pragma unroll
      for (int i = 0; i < 2; i++) {
        a[i] = *(const bf16x8*)(Qs + (wm * 64 + i * 32 + (lane & 31)) * 136 + ks * 16 + (lane >> 5) * 8);
        b[i] = *(const bf16x8*)(Ks + (wn * 64 + i * 32 + (lane & 31)) * 136 + ks * 16 + (lane >> 5) * 8);
      }
#pragma unroll
      for (int i = 0; i < 2; i++)
#pragma unroll
        for (int j = 0; j < 2; j++) acc[i][j] = __builtin_amdgcn_mfma_f32_32x32x16_bf16(a[i], b[j], acc[i][j], 0, 0, 0);
    }
    __syncthreads();
#pragma unroll
    for (int i = 0; i < 2; i++)
#pragma unroll
      for (int j = 0; j < 2; j++)
#pragma unroll
        for (int r = 0; r < 16; r++) {
          const int rowl = wm * 64 + i * 32 + (lane >> 5) * 4 + (r & 3) + 8 * (r >> 2);
          const int coll = wn * 64 + j * 32 + (lane & 31);
          Ss[rowl * 136 + coll + wn * 4] = acc[i][j][r];
        }
    __syncthreads();
    {
      const int row = tid >> 1, half = tid & 1;
      int L[16];
#pragma unroll
      for (int j = 0; j < 16; j++) L[j] = (int)0x80000000;
      const float4* sp = (const float4*)(Ss + row * 136 + half * 68);
#pragma unroll 1
      for (int blk = 0; blk < 4; blk++) {
        int bk[16];
#pragma unroll
        for (int c4 = 0; c4 < 4; c4++) {
          const float4 v = sp[blk * 4 + c4];
          const int cb = half * 64 + blk * 16 + c4 * 4;
          bk[c4 * 4 + 0] = (enc_key(v.x) & ~0x7F) | (cb + 0);
          bk[c4 * 4 + 1] = (enc_key(v.y) & ~0x7F) | (cb + 1);
          bk[c4 * 4 + 2] = (enc_key(v.z) & ~0x7F) | (cb + 2);
          bk[c4 * 4 + 3] = (enc_key(v.w) & ~0x7F) | (cb + 3);
        }
        sort16_desc(bk);
        merge16_desc(L, bk);
      }
      int m[16];
#pragma unroll
      for (int j = 0; j < 16; j++) m[j] = dpp_i<0xB1>(L[15 - j]);
#pragma unroll
      for (int j = 0; j < 16; j++) m[j] = max(m[j], L[j]);
#define BSTAGE(d_)                                                                                          \
  _Pragma("unroll") for (int j = 0; j < 16; j++) if ((j & (d_)) == 0) {                                    \
    const int hi = max(m[j], m[j + (d_)]), lo = min(m[j], m[j + (d_)]); m[j] = hi; m[j + (d_)] = lo; }
      BSTAGE(8) BSTAGE(4) BSTAGE(2) BSTAGE(1)
      int4* dst = (int4*)(KEYS + ((size_t)(tm * 128 + row) * 16 + tn) * 16);
      if (half == 0) {
        dst[0] = make_int4(m[0], m[1], m[2], m[3]);
        dst[1] = make_int4(m[4], m[5], m[6], m[7]);
      } else {
        dst[2] = make_int4(m[8], m[9], m[10], m[11]);
        dst[3] = make_int4(m[12], m[13], m[14], m[15]);
      }
    }
  }
}

__device__ __forceinline__ float gelu_exact(float x) { return 0.5f * x * (1.f + erff(x * 0.70710678118654752f)); }

__device__ __forceinline__ void phase_peer_route(const Params& p, int layer) {
  char* ws = p.ws;
  const int* KEYS = (const int*)(ws + (layer ? OFF_KEYS_1 : OFF_KEYS_0));
  int* EG = (int*)(ws + (layer ? OFF_KEYS_1 : OFF_KEYS_0) + 17432576);
  for (int it = blockIdx.x * 256 + threadIdx.x; it < TT * 8; it += gridDim.x * 256) {
    const int t = it >> 3, head = it & 7;
    const int* kz0 = KEYS + ((size_t)t * 16 + head * 2) * 16;
    const int* kz1 = kz0 + 16;
    int ka[16], kb[16];
#pragma unroll
    for (int j4 = 0; j4 < 4; j4++) {
      int4 x = ((const int4*)kz0)[j4]; ka[j4 * 4] = x.x; ka[j4 * 4 + 1] = x.y; ka[j4 * 4 + 2] = x.z; ka[j4 * 4 + 3] = x.w;
      int4 y = ((const int4*)kz1)[j4]; kb[j4 * 4] = y.x; kb[j4 * 4 + 1] = y.y; kb[j4 * 4 + 2] = y.z; kb[j4 * 4 + 3] = y.w;
    }
    float af[16], bf_[16];
#pragma unroll
    for (int j = 0; j < 16; j++) { af[j] = dec_key(ka[j] & ~0x7F); bf_[j] = dec_key(kb[j] & ~0x7F); }
    int L[16];
#pragma unroll
    for (int j = 0; j < 16; j++) L[j] = (int)0x80000000;
    {
      int bk[16];
      bk[0] = (enc_key(af[0] + bf_[0]) & ~0xFF) | (0);
      bk[1] = (enc_key(af[0] + bf_[1]) & ~0xFF) | (1);
      bk[2] = (enc_key(af[0] + bf_[2]) & ~0xFF) | (2);
      bk[3] = (enc_key(af[0] + bf_[3]) & ~0xFF) | (3);
      bk[4] = (enc_key(af[0] + bf_[4]) & ~0xFF) | (4);
      bk[5] = (enc_key(af[0] + bf_[5]) & ~0xFF) | (5);
      bk[6] = (enc_key(af[0] + bf_[6]) & ~0xFF) | (6);
      bk[7] = (enc_key(af[0] + bf_[7]) & ~0xFF) | (7);
      bk[8] = (enc_key(af[0] + bf_[8]) & ~0xFF) | (8);
      bk[9] = (enc_key(af[0] + bf_[9]) & ~0xFF) | (9);
      bk[10] = (enc_key(af[0] + bf_[10]) & ~0xFF) | (10);
      bk[11] = (enc_key(af[0] + bf_[11]) & ~0xFF) | (11);
      bk[12] = (enc_key(af[0] + bf_[12]) & ~0xFF) | (12);
      bk[13] = (enc_key(af[0] + bf_[13]) & ~0xFF) | (13);
      bk[14] = (enc_key(af[0] + bf_[14]) & ~0xFF) | (14);
      bk[15] = (enc_key(af[0] + bf_[15]) & ~0xFF) | (15);
      sort16_desc(bk); merge16_desc(L, bk);
      bk[0] = (enc_key(af[1] + bf_[0]) & ~0xFF) | (16);
      bk[1] = (enc_key(af[1] + bf_[1]) & ~0xFF) | (17);
      bk[2] = (enc_key(af[1] + bf_[2]) & ~0xFF) | (18);
      bk[3] = (enc_key(af[1] + bf_[3]) & ~0xFF) | (19);
      bk[4] = (enc_key(af[1] + bf_[4]) & ~0xFF) | (20);
      bk[5] = (enc_key(af[1] + bf_[5]) & ~0xFF) | (21);
      bk[6] = (enc_key(af[1] + bf_[6]) & ~0xFF) | (22);
      bk[7] = (enc_key(af[1] + bf_[7]) & ~0xFF) | (23);
      bk[8] = (enc_key(af[2] + bf_[0]) & ~0xFF) | (32);
      bk[9] = (enc_key(af[2] + bf_[1]) & ~0xFF) | (33);
      bk[10] = (enc_key(af[2] + bf_[2]) & ~0xFF) | (34);
      bk[11] = (enc_key(af[2] + bf_[3]) & ~0xFF) | (35);
      bk[12] = (enc_key(af[2] + bf_[4]) & ~0xFF) | (36);
      bk[13] = (enc_key(af[3] + bf_[0]) & ~0xFF) | (48);
      bk[14] = (enc_key(af[3] + bf_[1]) & ~0xFF) | (49);
      bk[15] = (enc_key(af[3] + bf_[2]) & ~0xFF) | (50);
      sort16_desc(bk); merge16_desc(L, bk);
      bk[0] = (enc_key(af[3] + bf_[3]) & ~0xFF) | (51);
      bk[1] = (enc_key(af[4] + bf_[0]) & ~0xFF) | (64);
      bk[2] = (enc_key(af[4] + bf_[1]) & ~0xFF) | (65);
      bk[3] = (enc_key(af[4] + bf_[2]) & ~0xFF) | (66);
      bk[4] = (enc_key(af[5] + bf_[0]) & ~0xFF) | (80);
      bk[5] = (enc_key(af[5] + bf_[1]) & ~0xFF) | (81);
      bk[6] = (enc_key(af[6] + bf_[0]) & ~0xFF) | (96);
      bk[7] = (enc_key(af[6] + bf_[1]) & ~0xFF) | (97);
      bk[8] = (enc_key(af[7] + bf_[0]) & ~0xFF) | (112);
      bk[9] = (enc_key(af[7] + bf_[1]) & ~0xFF) | (113);
      bk[10] = (enc_key(af[8] + bf_[0]) & ~0xFF) | (128);
      bk[11] = (enc_key(af[9] + bf_[0]) & ~0xFF) | (144);
      bk[12] = (enc_key(af[10] + bf_[0]) & ~0xFF) | (160);
      bk[13] = (enc_key(af[11] + bf_[0]) & ~0xFF) | (176);
      bk[14] = (enc_key(af[12] + bf_[0]) & ~0xFF) | (192);
      bk[15] = (enc_key(af[13] + bf_[0]) & ~0xFF) | (208);
      sort16_desc(bk); merge16_desc(L, bk);
      INS16(L, (enc_key(af[14] + bf_[0]) & ~0xFF) | (224));
      INS16(L, (enc_key(af[15] + bf_[0]) & ~0xFF) | (240));
    }
    float ev[16]; float esum = 0.f;
    const float smax = dec_key(L[0] & ~0xFF);
#pragma unroll
    for (int k = 0; k < 16; k++) { ev[k] = __expf(dec_key(L[k] & ~0xFF) - smax); esum += ev[k]; }
    const float inv = 1.f / esum;
    int* eo = EG + (size_t)t * 256 + head * 16;
    int ei[16];
#pragma unroll
    for (int k = 0; k < 16; k++) {
      const int ci = (L[k] >> 4) & 15, cj = L[k] & 15;
      ei[k] = (kz0[ci] & 127) * 128 + (kz1[cj] & 127);
    }
#pragma unroll
    for (int k4 = 0; k4 < 4; k4++) {
      ((int4*)eo)[k4] = make_int4(ei[k4 * 4], ei[k4 * 4 + 1], ei[k4 * 4 + 2], ei[k4 * 4 + 3]);
      ((float4*)(eo + 128))[k4] = make_float4(ev[k4 * 4] * inv, ev[k4 * 4 + 1] * inv, ev[k4 * 4 + 2] * inv, ev[k4 * 4 + 3] * inv);
    }
  }
}

__device__ __forceinline__ float rs16(float (&q)[16], int lane) {
  const bool b0 = lane & 1, b1 = lane & 2, b2 = lane & 4, b3 = lane & 8;
  float a[8];
#pragma unroll
  for (int i = 0; i < 8; i++) { const float keep = b0 ? q[i + 8] : q[i], send = b0 ? q[i] : q[i + 8]; a[i] = keep + dpp_f<0xB1>(send); }
  float c[4];
#pragma unroll
  for (int i = 0; i < 4; i++) { const float keep = b1 ? a[i + 4] : a[i], send = b1 ? a[i] : a[i + 4]; c[i] = keep + dpp_f<0x4E>(send); }
  float d[2];
#pragma unroll
  for (int i = 0; i < 2; i++) { const float keep = b2 ? c[i + 2] : c[i], send = b2 ? c[i] : c[i + 2]; d[i] = keep + dpp_f<0x1B>(dpp_f<0x141>(send)); }
  const float keep = b3 ? d[1] : d[0], send = b3 ? d[0] : d[1];
  float v = keep + dpp_f<0x141>(dpp_f<0x140>(send));
  v += __shfl_xor(v, 16);
  v += __shfl_xor(v, 32);
  return v;
}
__device__ __forceinline__ constexpr int bitrev4(int x) { return ((x & 1) << 3) | ((x & 2) << 1) | ((x & 4) >> 1) | ((x & 8) >> 3); }

__device__ __forceinline__ void phase_peer_expert(const Params& p, int layer, char* smem, bool dry = false) {
  const int tid = threadIdx.x, lane = tid & 63, wave = tid >> 6;
  char* ws = p.ws;
  float* H = (float*)(ws + OFF_H);
  const bf16_t* XN2 = (const bf16_t*)(ws + (layer ? OFF_XN2_1 : OFF_XN2_0));
  const int* EG = (const int*)(ws + (layer ? OFF_KEYS_1 : OFF_KEYS_0) + 17432576);
  const uint2* Ub = (const uint2*)(ws + OFF_TAB) + (size_t)(layer * 2) * 16384 * 64;
  const uint2* Vb = Ub + (size_t)16384 * 64;
  const float* SCu = (const float*)(ws + WT_SC) + (layer * 2) * 16384;
  const float* SCv = SCu + 16384;
  const float* gn = layer ? p.in[9] : (p.in[7] + DM);
  const int pslot = (lane & 48) + bitrev4(lane & 15);
  const int per_round = gridDim.x * 4;
  const int nfull = TT / per_round;
  const int tail0 = nfull * per_round;
  const int ntail = TT - tail0;
  const int my_tail = ((int)blockIdx.x < ntail) ? ((ntail - 1 - (int)blockIdx.x) / (int)gridDim.x + 1) : 0;
  float* part = (float*)smem;
  for (int it = 0; it < nfull + my_tail; it++) {
    const bool coop = it >= nfull;
    const int t = coop ? (tail0 + (int)blockIdx.x + (it - nfull) * (int)gridDim.x) : (it * per_round + (int)blockIdx.x * 4 + wave);
    const int eb0 = coop ? wave * 32 : 0, eb1 = coop ? eb0 + 32 : 128;
    const int* eg = EG + (size_t)t * 256;
    const int e_lin0 = eg[lane], e_lin1 = eg[64 + lane];
    const int e_lo = eg[pslot], e_hi = eg[64 + pslot];
    const float g_lo = __int_as_float(eg[128 + pslot]), g_hi = __int_as_float(eg[192 + pslot]);
    const float su_lo = SCu[e_lo], su_hi = SCu[e_hi], sv_lo = SCv[e_lo], sv_hi = SCv[e_hi];
    f32x2_t x2[8];
    {
      const uint4 xa = *(const uint4*)(XN2 + (size_t)t * DM + lane * 16);
      const uint4 xb = *(const uint4*)(XN2 + (size_t)t * DM + lane * 16 + 8);
      x2[0] = f32x2_t{bflo(xa.x), bfhi(xa.x)}; x2[1] = f32x2_t{bflo(xa.y), bfhi(xa.y)};
      x2[2] = f32x2_t{bflo(xa.z), bfhi(xa.z)}; x2[3] = f32x2_t{bflo(xa.w), bfhi(xa.w)};
      x2[4] = f32x2_t{bflo(xb.x), bfhi(xb.x)}; x2[5] = f32x2_t{bflo(xb.y), bfhi(xb.y)};
      x2[6] = f32x2_t{bflo(xb.z), bfhi(xb.z)}; x2[7] = f32x2_t{bflo(xb.w), bfhi(xb.w)};
    }
    float d0 = 0.f, d1 = 0.f;
    for (int eb = eb0; eb < eb1; eb += 32) {
      const int esel = (eb < 64) ? e_lin0 : e_lin1;
      uint2 ua[32];
#pragma unroll
      for (int j = 0; j < 32; j++) {
        const int row = __builtin_amdgcn_readlane(esel, (eb + j) & 63);
        ua[j] = (Ub + (size_t)row * 64)[lane];
      }
#pragma unroll
      for (int hb = 0; hb < 2; hb++) {
        float q[16];
#pragma unroll
        for (int j = 0; j < 16; j++) {
          const uint2 u = ua[hb * 16 + j];
          f32x2_t a2 = __builtin_amdgcn_cvt_scalef32_pk_f32_fp4(u.x, 1.0f, 0) * x2[0];
          a2 += __builtin_amdgcn_cvt_scalef32_pk_f32_fp4(u.x, 1.0f, 1) * x2[1];
          a2 += __builtin_amdgcn_cvt_scalef32_pk_f32_fp4(u.x, 1.0f, 2) * x2[2];
          a2 += __builtin_amdgcn_cvt_scalef32_pk_f32_fp4(u.x, 1.0f, 3) * x2[3];
          a2 += __builtin_amdgcn_cvt_scalef32_pk_f32_fp4(u.y, 1.0f, 0) * x2[4];
          a2 += __builtin_amdgcn_cvt_scalef32_pk_f32_fp4(u.y, 1.0f, 1) * x2[5];
          a2 += __builtin_amdgcn_cvt_scalef32_pk_f32_fp4(u.y, 1.0f, 2) * x2[6];
          a2 += __builtin_amdgcn_cvt_scalef32_pk_f32_fp4(u.y, 1.0f, 3) * x2[7];
          q[j] = a2.x + a2.y;
        }
        const float v = rs16(q, lane);
        const int bt = (eb >> 4) + hb;
        if ((lane >> 4) == (bt & 3)) { if (bt < 4) d0 = v; else d1 = v; }
      }
    }
    const float c0 = g_lo * gelu_exact(d0 * su_lo) * sv_lo;
    const float c1 = g_hi * gelu_exact(d1 * su_hi) * sv_hi;
    f32x2_t o2[8];
#pragma unroll
    for (int i = 0; i < 8; i++) o2[i] = f32x2_t{0.f, 0.f};
    for (int eb = eb0; eb < eb1; eb += 32) {
      const int esel = (eb < 64) ? e_lin0 : e_lin1;
      uint2 va[32];
#pragma unroll
      for (int j = 0; j < 32; j++) {
        const int row = __builtin_amdgcn_readlane(esel, (eb + j) & 63);
        va[j] = (Vb + (size_t)row * 64)[lane];
      }
      const float csel = (eb < 64) ? c0 : c1;
      const int rbase = ((eb >> 4) & 3) * 16;
#pragma unroll
      for (int j = 0; j < 32; j++) {
        const float c = rdlane(csel, rbase + (j >> 4) * 16 + bitrev4(j & 15));
        const f32x2_t cc = f32x2_t{c, c};
        o2[0] += cc * __builtin_amdgcn_cvt_scalef32_pk_f32_fp4(va[j].x, 1.0f, 0);
        o2[1] += cc * __builtin_amdgcn_cvt_scalef32_pk_f32_fp4(va[j].x, 1.0f, 1);
        o2[2] += cc * __builtin_amdgcn_cvt_scalef32_pk_f32_fp4(va[j].x, 1.0f, 2);
        o2[3] += cc * __builtin_amdgcn_cvt_scalef32_pk_f32_fp4(va[j].x, 1.0f, 3);
        o2[4] += cc * __builtin_amdgcn_cvt_scalef32_pk_f32_fp4(va[j].y, 1.0f, 0);
        o2[5] += cc * __builtin_amdgcn_cvt_scalef32_pk_f32_fp4(va[j].y, 1.0f, 1);
        o2[6] += cc * __builtin_amdgcn_cvt_scalef32_pk_f32_fp4(va[j].y, 1.0f, 2);
        o2[7] += cc * __builtin_amdgcn_cvt_scalef32_pk_f32_fp4(va[j].y, 1.0f, 3);
      }
    }
    if (coop) {
      __syncthreads();
#pragma unroll
      for (int f4 = 0; f4 < 4; f4++)
        *(float4*)(part + wave * 1024 + lane * 16 + f4 * 4) = make_float4(o2[f4 * 2].x, o2[f4 * 2].y, o2[f4 * 2 + 1].x, o2[f4 * 2 + 1].y);
      __syncthreads();
      if (wave != 0) continue;
#pragma unroll
      for (int w = 1; w < 4; w++)
#pragma unroll
        for (int f4 = 0; f4 < 4; f4++) {
          const float4 v = *(const float4*)(part + w * 1024 + lane * 16 + f4 * 4);
          o2[f4 * 2].x += v.x; o2[f4 * 2].y += v.y; o2[f4 * 2 + 1].x += v.z; o2[f4 * 2 + 1].y += v.w;
        }
    }
    float* hp = H + (size_t)t * DM + lane * 16;
    float hn[16]; float ss = 0.f;
#pragma unroll
    for (int f4 = 0; f4 < 4; f4++) {
      const float4 v = *(const float4*)(hp + f4 * 4);
      const int i = f4 * 4;
      hn[i] = v.x + o2[f4 * 2].x; hn[i + 1] = v.y + o2[f4 * 2].y; hn[i + 2] = v.z + o2[f4 * 2 + 1].x; hn[i + 3] = v.w + o2[f4 * 2 + 1].y;
      ss += hn[i] * hn[i] + hn[i + 1] * hn[i + 1] + hn[i + 2] * hn[i + 2] + hn[i + 3] * hn[i + 3];
    }
    ss = wave_sum(ss);
    const float rstd = rsqrtf(ss * (1.f / 1024.f) + 1e-5f);
    float yn[16];
#pragma unroll
    for (int f4 = 0; f4 < 4; f4++) {
      const float4 g = *(const float4*)(gn + lane * 16 + f4 * 4);
      const int i = f4 * 4;
      yn[i] = hn[i] * rstd * g.x; yn[i + 1] = hn[i + 1] * rstd * g.y; yn[i + 2] = hn[i + 2] * rstd * g.z; yn[i + 3] = hn[i + 3] * rstd * g.w;
    }
    if (dry && rstd != 123.456f) continue;
    if (layer == 0) {
      bf16_t* xnm = (bf16_t*)(ws + OFF_XNM) + (size_t)t * DM + lane * 16;
#pragma unroll
      for (int f4 = 0; f4 < 4; f4++) *(float4*)(hp + f4 * 4) = make_float4(hn[f4 * 4], hn[f4 * 4 + 1], hn[f4 * 4 + 2], hn[f4 * 4 + 3]);
      *(uint4*)(xnm) = make_uint4(cvtpk(yn[0], yn[1]), cvtpk(yn[2], yn[3]), cvtpk(yn[4], yn[5]), cvtpk(yn[6], yn[7]));
      *(uint4*)(xnm + 8) = make_uint4(cvtpk(yn[8], yn[9]), cvtpk(yn[10], yn[11]), cvtpk(yn[12], yn[13]), cvtpk(yn[14], yn[15]));
    } else {
      float* dst = nullptr;
      if (t < TP) { const int b = t / LP, l = t - b * LP; if (l >= 16) dst = p.out + OUT0 + ((size_t)b * 2048 + (l - 16)) * DM; }
      else dst = p.out + OUT1 + (size_t)(t - TP) * DM;
      if (dst) {
#pragma unroll
        for (int f4 = 0; f4 < 4; f4++) *(float4*)(dst + lane * 16 + f4 * 4) = make_float4(yn[f4 * 4], yn[f4 * 4 + 1], yn[f4 * 4 + 2], yn[f4 * 4 + 3]);
      }
    }
  }
}

__device__ __forceinline__ void phase_mamba_inproj(const Params& p, char* smem) {
  bf16_t* sA = (bf16_t*)smem; bf16_t* sB = sA + 128 * SAS;
  char* ws = p.ws;
  bf16_t* Z = (bf16_t*)(ws + OFF_Z); bf16_t* XBC = (bf16_t*)(ws + OFF_XBC); float* DTR = (float*)(ws + OFF_DTR);
  for (int kk_ = 0;; kk_++) {
    int tm, tn;
    if (!xcd_tile(kk_, 133, 41, tm, tn)) break;
    GemmA ga; ga.A = (const bf16_t*)(ws + OFF_XNM); ga.lda = DM; ga.mix = nullptr; ga.sh0 = nullptr; ga.zero = nullptr;
    f32x16 acc[2][2];
    if (tn < 40) {
      gemm_mainloop<0, 1>(acc, ga, (const bf16_t*)(ws + WT_IN), 1024, 5152, 1024, tm * 128, tn * 128, sA, sB);
      if (tn < 16) gemm_epilogue_bf16_lds(acc, Z, 2048, tm * 128, tn * 128, 0, sA, [&](int, float v) { return v; });
      else gemm_epilogue_bf16_lds(acc, XBC, 3072, tm * 128, tn * 128 - 2048, 0, sA, [&](int, float v) { return v; });
      continue;
    }
    gemm_mainloop<0>(acc, ga, (const bf16_t*)(ws + WT_IN), 1024, 5152, 1024, tm * 128, tn * 128, sA, sB);
    if (tn < 16) {
      gemm_epilogue(acc, tm * 128, tn * 128, [&](int row, int col, float v) { Z[(size_t)row * 2048 + col] = f2bf(v); });
    } else if (tn < 40) {
      gemm_epilogue(acc, tm * 128, tn * 128 - 2048, [&](int row, int col, float v) { XBC[(size_t)row * 3072 + col] = f2bf(v); });
    } else {
      gemm_epilogue(acc, tm * 128, 0, [&](int row, int col, float v) { if (col < 32) DTR[(size_t)row * 32 + col] = v; });
    }
  }
}

__device__ __forceinline__ void phase_mamba_conv(const Params& p) {
  char* ws = p.ws;
  const bf16_t* XBC = (const bf16_t*)(ws + OFF_XBC);
  bf16_t* XC = (bf16_t*)(ws + OFF_XC);
  const float* cw = p.in[27]; const float* cb = p.in[28];
  for (int it = blockIdx.x * 256 + threadIdx.x; it < TT * 384; it += gridDim.x * 256) {
    const int t = it / 384, c8 = (it - t * 384) * 8;
    int b, l; const float* c0 = nullptr;
    if (t < TP) { b = t / LP; l = t - b * LP; } else { const int s = t - TP; b = s >> 2; l = s & 3; c0 = p.in[4] + (size_t)b * 9216; }
    float acc[8];
    {
      const float4 b0 = *(const float4*)(cb + c8), b1 = *(const float4*)(cb + c8 + 4);
      acc[0] = b0.x; acc[1] = b0.y; acc[2] = b0.z; acc[3] = b0.w; acc[4] = b1.x; acc[5] = b1.y; acc[6] = b1.z; acc[7] = b1.w;
    }
#pragma unroll
    for (int j = 0; j < 4; j++) {
      const int ll = l - 3 + j;
      float x[8];
      if (ll >= 0) {
        unpack8(*(const uint4*)(XBC + (size_t)(t - 3 + j) * 3072 + c8), x);
      } else if (c0) {
        const float4 v0 = *(const float4*)(c0 + (3 + ll) * 3072 + c8), v1 = *(const float4*)(c0 + (3 + ll) * 3072 + c8 + 4);
        x[0] = v0.x; x[1] = v0.y; x[2] = v0.z; x[3] = v0.w; x[4] = v1.x; x[5] = v1.y; x[6] = v1.z; x[7] = v1.w;
      } else {
#pragma unroll
        for (int e = 0; e < 8; e++) x[e] = 0.f;
      }
      const float4 w0 = *(const float4*)(cw + j * 3072 + c8), w1 = *(const float4*)(cw + j * 3072 + c8 + 4);
      acc[0] += w0.x * x[0]; acc[1] += w0.y * x[1]; acc[2] += w0.z * x[2]; acc[3] += w0.w * x[3];
      acc[4] += w1.x * x[4]; acc[5] += w1.y * x[5]; acc[6] += w1.z * x[6]; acc[7] += w1.w * x[7];
    }
#pragma unroll
    for (int e = 0; e < 8; e++) acc[e] = acc[e] * sigmoidf_(acc[e]);
    *(uint4*)(XC + (size_t)t * 3072 + c8) = pack8(acc);
  }
}

#define MCH 16
#define MSTRIDE (MCH * 136 * 2 + MCH * 64 * 2 + 2 * MCH)
__device__ __forceinline__ int padn(int n) { return n + ((n >> 6) << 2); }
struct MVec { float4 B[4], C[4]; float2 xx; float dt, dA; };
__device__ __forceinline__ void mamba_ld(MVec& m, const float* sB, int st, int nq, int pp) {
#pragma unroll
  for (int j4 = 0; j4 < 4; j4++) {
    m.B[j4] = *(const float4*)(sB + st * 136 + padn(nq * 16 + j4 * 4));
    m.C[j4] = *(const float4*)(sB + MCH * 136 + st * 136 + padn(nq * 16 + j4 * 4));
  }
  m.xx = *(const float2*)(sB + 2 * MCH * 136 + st * 64 + 2 * pp);
  m.dt = sB[2 * MCH * 136 + 2 * MCH * 64 + st];
  m.dA = sB[2 * MCH * 136 + 2 * MCH * 64 + MCH + st];
}
__device__ __forceinline__ float2 mamba_step(f32x2_t (&hs)[2][8], const MVec& m, float Dk) {
  const float xd0 = m.xx.x * m.dt, xd1 = m.xx.y * m.dt;
  const f32x2_t dA2 = f32x2_t{m.dA, m.dA}, xd0v = f32x2_t{xd0, xd0}, xd1v = f32x2_t{xd1, xd1};
  f32x2_t y0 = f32x2_t{0.f, 0.f}, y1 = f32x2_t{0.f, 0.f};
#pragma unroll
  for (int j4 = 0; j4 < 4; j4++) {
    const f32x2_t Ba = f32x2_t{m.B[j4].x, m.B[j4].y}, Bb = f32x2_t{m.B[j4].z, m.B[j4].w};
    const f32x2_t Ca = f32x2_t{m.C[j4].x, m.C[j4].y}, Cb = f32x2_t{m.C[j4].z, m.C[j4].w};
    const int j = j4 * 2;
    hs[0][j] = hs[0][j] * dA2 + xd0v * Ba; hs[0][j + 1] = hs[0][j + 1] * dA2 + xd0v * Bb;
    hs[1][j] = hs[1][j] * dA2 + xd1v * Ba; hs[1][j + 1] = hs[1][j + 1] * dA2 + xd1v * Bb;
    y0 += Ca * hs[0][j]; y0 += Cb * hs[0][j + 1];
    y1 += Ca * hs[1][j]; y1 += Cb * hs[1][j + 1];
  }
  const float ys0 = oct_sum(y0.x + y0.y), ys1 = oct_sum(y1.x + y1.y);
  return make_float2(ys0 + Dk * m.xx.x, ys1 + Dk * m.xx.y);
}
__device__ __forceinline__ void mamba_scan_item(const Params& p, int item, float* sm) {
  const int tid = threadIdx.x;
  char* ws = p.ws;
  int b, hd, L, t0; const float* h0; float* hout;
  if (item < 256) { b = item >> 5; hd = item & 31; L = LP; t0 = b * LP; h0 = nullptr; hout = p.out + OUT5 + (size_t)item * 8192; }
  else { int s = item - 256; b = s >> 5; hd = s & 31; L = 4; t0 = TP + b * 4; h0 = p.in[5] + (size_t)s * 8192; hout = p.out + OUT9 + (size_t)s * 8192; }
  const int g = hd >> 3;
  const int pp = tid >> 3, nq = tid & 7;
  f32x2_t hs[2][8];
#pragma unroll
  for (int i = 0; i < 2; i++)
#pragma unroll
    for (int j4 = 0; j4 < 4; j4++) {
      float4 v = make_float4(0.f, 0.f, 0.f, 0.f);
      if (h0) v = *(const float4*)(h0 + (2 * pp + i) * 128 + nq * 16 + j4 * 4);
      hs[i][j4 * 2] = f32x2_t{v.x, v.y}; hs[i][j4 * 2 + 1] = f32x2_t{v.z, v.w};
    }
  const float dtb = p.in[29][hd], Aneg = -__expf(p.in[30][hd]), Dk = p.in[31][hd];
  const bf16_t* XC = (const bf16_t*)(ws + OFF_XC);
  const float* DTR = (const float*)(ws + OFF_DTR);
  bf16_t* Y2 = (bf16_t*)(ws + OFF_Y2);
  const int fst = tid >> 4, fq = tid & 15;
  struct PF { uint4 fB, fC; uint2 fX; float dtr; };
  PF pfA, pfB;
  auto prefetch = [&](PF& f, int c0) {
    if (c0 + fst < L) {
      const size_t tok = (size_t)(t0 + c0 + fst);
      f.fB = *(const uint4*)(XC + tok * 3072 + 2048 + g * 128 + fq * 8);
      f.fC = *(const uint4*)(XC + tok * 3072 + 2560 + g * 128 + fq * 8);
      f.fX = *(const uint2*)(XC + tok * 3072 + hd * 64 + fq * 4);
      if (fq == 0) f.dtr = DTR[tok * 32 + hd];
    }
  };
  auto chunk = [&](PF& f, int c0, int par) {
    float* sB = sm + par * MSTRIDE;
    float* sYv = sB + 2 * MCH * 136 + MCH * 64;
    if (c0 + fst < L) {
      float v[8];
      unpack8(f.fB, v);
      *(float4*)(sB + fst * 136 + padn(fq * 8)) = make_float4(v[0], v[1], v[2], v[3]);
      *(float4*)(sB + fst * 136 + padn(fq * 8 + 4)) = make_float4(v[4], v[5], v[6], v[7]);
      unpack8(f.fC, v);
      *(float4*)(sB + MCH * 136 + fst * 136 + padn(fq * 8)) = make_float4(v[0], v[1], v[2], v[3]);
      *(float4*)(sB + MCH * 136 + fst * 136 + padn(fq * 8 + 4)) = make_float4(v[4], v[5], v[6], v[7]);
      *(float4*)(sB + 2 * MCH * 136 + fst * 64 + fq * 4) = make_float4(bflo(f.fX.x), bfhi(f.fX.x), bflo(f.fX.y), bfhi(f.fX.y));
      if (fq == 0) {
        const float dt = softplusf_(f.dtr + dtb);
        sB[2 * MCH * 136 + 2 * MCH * 64 + fst] = dt;
        sB[2 * MCH * 136 + 2 * MCH * 64 + MCH + fst] = __expf(dt * Aneg);
      }
    }
    __syncthreads();
    if (c0 + 2 * MCH < L) prefetch(f, c0 + 2 * MCH);
    const int nst = min(MCH, L - c0);
    MVec ma, mb;
    mamba_ld(ma, sB, 0, nq, pp);
    for (int st = 0; st < nst; st += 2) {
      mamba_ld(mb, sB, st + 1, nq, pp);
      const float2 ya = mamba_step(hs, ma, Dk);
      if (nq == 0) *(float2*)(sYv + st * 64 + 2 * pp) = ya;
      if (st + 2 < nst) mamba_ld(ma, sB, st + 2, nq, pp);
      const float2 yb = mamba_step(hs, mb, Dk);
      if (nq == 0) *(float2*)(sYv + (st + 1) * 64 + 2 * pp) = yb;
    }
    __syncthreads();
    if (c0 + fst < L) {
      const float4 v = *(const float4*)(sYv + fst * 64 + fq * 4);
      *(uint2*)(Y2 + (size_t)(t0 + c0 + fst) * 2048 + hd * 64 + fq * 4) = make_uint2(cvtpk(v.x, v.y), cvtpk(v.z, v.w));
    }
  };
  prefetch(pfA, 0);
  if (MCH < L) prefetch(pfB, MCH);
  for (int c0 = 0; c0 < L; c0 += 2 * MCH) {
    chunk(pfA, c0, 0);
    if (c0 + MCH < L) chunk(pfB, c0 + MCH, 1);
  }
#pragma unroll
  for (int i = 0; i < 2; i++)
#pragma unroll
    for (int j4 = 0; j4 < 4; j4++)
      *(float4*)(hout + (2 * pp + i) * 128 + nq * 16 + j4 * 4) =
          make_float4(hs[i][j4 * 2].x, hs[i][j4 * 2].y, hs[i][j4 * 2 + 1].x, hs[i][j4 * 2 + 1].y);
  __syncthreads();
}

#define MQ 64
__device__ __forceinline__ bf16x8 pack_acc8(const f32x16& a, int o) {
  uint4 u = make_uint4(cvtpk(a[o], a[o + 1]), cvtpk(a[o + 2], a[o + 3]), cvtpk(a[o + 4], a[o + 5]), cvtpk(a[o + 6], a[o + 7]));
  return __builtin_bit_cast(bf16x8, u);
}
__device__ __forceinline__ void mamba_chunk_item(const Params& p, int item, char* smem) {
  const int tid = threadIdx.x, lane = tid & 63, wave = tid >> 6;
  const int l31 = lane & 31, g2 = lane >> 5;
  char* ws = p.ws;
  const int b = item >> 5, hd = item & 31, g = hd >> 3;
  const int t0 = b * LP;
  bf16_t* Cs = (bf16_t*)smem;
  bf16_t* Bs = Cs + 64 * 136;
  bf16_t* Ms = Bs;
  bf16_t* Bt = Bs + 64 * 136;
  bf16_t* Xt = Bt + 128 * 72;
  bf16_t* Xt2 = Xt + 64 * 72;
  float* sCs = (float*)(Xt2 + 64 * 72);
  float* sDt = sCs + 64;
  const float dtb = p.in[29][hd], Aneg = -__expf(p.in[30][hd]), Dk = p.in[31][hd];
  const bf16_t* XC = (const bf16_t*)(ws + OFF_XC);
  const float* DTR = (const float*)(ws + OFF_DTR);
  bf16_t* Y2 = (bf16_t*)(ws + OFF_Y2);
  const int wi = wave >> 1, wj = wave & 1;
  f32x16 hT[4];
#pragma unroll
  for (int nb = 0; nb < 4; nb++)
#pragma unroll
    for (int r = 0; r < 16; r++) hT[nb][r] = 0.f;
  const int fs = tid >> 2, q4 = tid & 3;
  uint4 fC[4], fB[4], fX[2]; float fdt = 0.f;
  auto prefetch = [&](int c0) {
    const bool valid = (c0 + fs) < LP;
    const bf16_t* rowp = XC + (size_t)(t0 + c0 + fs) * 3072;
#pragma unroll
    for (int i = 0; i < 4; i++) {
      const int q = q4 * 4 + i;
      fC[i] = valid ? *(const uint4*)(rowp + 2560 + g * 128 + q * 8) : make_uint4(0, 0, 0, 0);
      fB[i] = valid ? *(const uint4*)(rowp + 2048 + g * 128 + q * 8) : make_uint4(0, 0, 0, 0);
    }
#pragma unroll
    for (int i = 0; i < 2; i++) {
      const int q = q4 * 2 + i;
      fX[i] = valid ? *(const uint4*)(rowp + hd * 64 + q * 8) : make_uint4(0, 0, 0, 0);
    }
    if (wave == 0) fdt = ((c0 + lane) < LP) ? DTR[(size_t)(t0 + c0 + lane) * 32 + hd] : -1e30f;
  };
  prefetch(0);
  for (int c0 = 0; c0 < LP; c0 += MQ) {
    if (wave == 0) {
      const float dt = (c0 + lane < LP) ? softplusf_(fdt + dtb) : 0.f;
      float cs = dt * Aneg;
#pragma unroll
      for (int d = 1; d < 64; d <<= 1) { const float o = __shfl_up(cs, d); if (lane >= d) cs += o; }
      sCs[lane] = cs; sDt[lane] = dt;
    }
#pragma unroll
    for (int i = 0; i < 4; i++) {
      const int q = q4 * 4 + i;
      *(uint4*)(Cs + fs * 136 + q * 8) = fC[i];
      *(uint4*)(Bs + fs * 136 + q * 8) = fB[i];
      const unsigned w[4] = {fB[i].x, fB[i].y, fB[i].z, fB[i].w};
#pragma unroll
      for (int e = 0; e < 4; e++) {
        Bt[(q * 8 + 2 * e) * 72 + fs] = (bf16_t)(w[e] & 0xffffu);
        Bt[(q * 8 + 2 * e + 1) * 72 + fs] = (bf16_t)(w[e] >> 16);
      }
    }
    __syncthreads();
    {
      const float csQ = sCs[63];
      const float sc = sDt[fs] * __expf(csQ - sCs[fs]);
#pragma unroll
      for (int i = 0; i < 2; i++) {
        const int q = q4 * 2 + i;
        const unsigned w[4] = {fX[i].x, fX[i].y, fX[i].z, fX[i].w};
#pragma unroll
        for (int e = 0; e < 4; e++) {
          Xt[(q * 8 + 2 * e) * 72 + fs] = (bf16_t)(w[e] & 0xffffu);
          Xt[(q * 8 + 2 * e + 1) * 72 + fs] = (bf16_t)(w[e] >> 16);
          const unsigned pk = cvtpk(bflo(w[e]) * sc, bfhi(w[e]) * sc);
          Xt2[(q * 8 + 2 * e) * 72 + fs] = (bf16_t)(pk & 0xffffu);
          Xt2[(q * 8 + 2 * e + 1) * 72 + fs] = (bf16_t)(pk >> 16);
        }
      }
    }
    if (c0 + MQ < LP) prefetch(c0 + MQ);
    f32x16 gacc;
#pragma unroll
    for (int r = 0; r < 16; r++) gacc[r] = 0.f;
    const bool doG = !(wi == 0 && wj == 1);
    if (doG) {
#pragma unroll
      for (int ks = 0; ks < 8; ks++) {
        const bf16x8 a = *(const bf16x8*)(Cs + (wi * 32 + l31) * 136 + ks * 16 + g2 * 8);
        const bf16x8 bb = *(const bf16x8*)(Bs + (wj * 32 + l31) * 136 + ks * 16 + g2 * 8);
        gacc = __builtin_amdgcn_mfma_f32_32x32x16_bf16(a, bb, gacc, 0, 0, 0);
      }
    }
    f32x16 yacc;
#pragma unroll
    for (int r = 0; r < 16; r++) yacc[r] = 0.f;
#pragma unroll
    for (int nb = 0; nb < 4; nb++)
#pragma unroll
      for (int kk = 0; kk < 2; kk++) {
        const bf16_t* cp = Cs + (wi * 32 + l31) * 136 + nb * 32 + kk * 16 + 4 * g2;
        const uint2 lo = *(const uint2*)(cp), hi = *(const uint2*)(cp + 8);
        const uint4 au = make_uint4(lo.x, lo.y, hi.x, hi.y);
        yacc = __builtin_amdgcn_mfma_f32_32x32x16_bf16(__builtin_bit_cast(bf16x8, au), pack_acc8(hT[nb], kk * 8), yacc, 0, 0, 0);
      }
    __syncthreads();
    if (doG) {
      const int scol = wj * 32 + l31;
      const float cs_s = sCs[scol], dt_s = sDt[scol];
#pragma unroll
      for (int r = 0; r < 16; r++) {
        const int l = wi * 32 + g2 * 4 + (r & 3) + 8 * (r >> 2);
        float v = 0.f;
        if (scol <= l) v = gacc[r] * __expf(sCs[l] - cs_s) * dt_s;
        if (scol == l) v += Dk;
        Ms[l * 72 + scol] = f2bf(v);
      }
    } else {
#pragma unroll
      for (int r = 0; r < 16; r++) {
        const int l = g2 * 4 + (r & 3) + 8 * (r >> 2);
        Ms[l * 72 + 32 + l31] = 0;
      }
    }
#pragma unroll
    for (int r = 0; r < 16; r++) {
      const int l = wi * 32 + g2 * 4 + (r & 3) + 8 * (r >> 2);
      yacc[r] *= __expf(sCs[l]);
    }
    __syncthreads();
#pragma unroll
    for (int ks = 0; ks < 4; ks++) {
      const bf16x8 a = *(const bf16x8*)(Ms + (wi * 32 + l31) * 72 + ks * 16 + g2 * 8);
      const bf16x8 bb = *(const bf16x8*)(Xt + (wj * 32 + l31) * 72 + ks * 16 + g2 * 8);
      yacc = __builtin_amdgcn_mfma_f32_32x32x16_bf16(a, bb, yacc, 0, 0, 0);
    }
#pragma unroll
    for (int r = 0; r < 16; r++) {
      const int l = wi * 32 + g2 * 4 + (r & 3) + 8 * (r >> 2);
      if (c0 + l < LP) Y2[(size_t)(t0 + c0 + l) * 2048 + hd * 64 + wj * 32 + l31] = f2bf(yacc[r]);
    }
    {
      const float dec = __expf(sCs[63]);
#pragma unroll
      for (int nb = 0; nb < 4; nb++) {
#pragma unroll
        for (int r = 0; r < 16; r++) hT[nb][r] *= dec;
#pragma unroll
        for (int ks = 0; ks < 4; ks++) {
          const bf16x8 a = *(const bf16x8*)(Bt + (nb * 32 + l31) * 72 + ks * 16 + g2 * 8);
          const bf16x8 bb = *(const bf16x8*)(Xt2 + (wj * 32 + l31) * 72 + ks * 16 + g2 * 8);
          hT[nb] = __builtin_amdgcn_mfma_f32_32x32x16_bf16(a, bb, hT[nb], 0, 0, 0);
        }
      }
    }
    __syncthreads();
  }
  if (wi == 0) {
    float* hout = p.out + OUT5 + (size_t)item * 8192;
#pragma unroll
    for (int nb = 0; nb < 4; nb++)
#pragma unroll
      for (int r = 0; r < 16; r++) {
        const int n = nb * 32 + 8 * (r >> 2) + 4 * g2 + (r & 3);
        hout[(wj * 32 + l31) * 128 + n] = hT[nb][r];
      }
  }
}

__device__ __forceinline__ void phase_mamba_scan(const Params& p, char* smem) {
  const int nb = gridDim.x, bid = blockIdx.x;
  {
    const bf16_t* XBC = (const bf16_t*)(p.ws + OFF_XBC);
    for (int i = bid * 256 + threadIdx.x; i < (8 + 128) * 9216; i += nb * 256) {
      if (i < 8 * 9216) {
        const int b = i / 9216, r = i - b * 9216, j = r / 3072, c = r - j * 3072;
        p.out[OUT4 + i] = bf2f(XBC[(size_t)(b * LP + LP - 3 + j) * 3072 + c]);
      } else {
        const int ii = i - 8 * 9216;
        const int b = ii / 9216, r = ii - b * 9216, j = r / 3072, c = r - j * 3072;
        p.out[OUT8 + ii] = bf2f(XBC[(size_t)(TP + b * 4 + 1 + j) * 3072 + c]);
      }
    }
  }
  if (nb > 320) {
    if (bid < 256) mamba_chunk_item(p, bid, smem);
    else {
      for (int it = bid; it < 256 + 4096; it += nb - 256) mamba_scan_item(p, it, (float*)smem);
      convert_tables_fp8(p, bid - 256, nb - 256, 1);
    }
  } else {
    for (int it = bid; it < 256; it += nb) mamba_chunk_item(p, it, smem);
    for (int it = 256 + bid; it < 256 + 4096; it += nb) mamba_scan_item(p, it, (float*)smem);
    convert_tables_fp8(p, bid, nb, 1);
  }
}

__device__ __forceinline__ void phase_mamba_gate(const Params& p) {
  const int tid = threadIdx.x, lane = tid & 63, wave = tid >> 6;
  char* ws = p.ws;
  const bf16_t* Y2 = (const bf16_t*)(ws + OFF_Y2); const bf16_t* Z = (const bf16_t*)(ws + OFF_Z);
  bf16_t* YG = (bf16_t*)(ws + OFF_YG);
  const float* nw = p.in[32];
  for (int t = blockIdx.x * 4 + wave; t < TT; t += gridDim.x * 4) {
#pragma unroll
    for (int c = 0; c < 4; c++) {
      const size_t off = (size_t)t * 2048 + c * 512 + lane * 8;
      const uint4 yv = *(const uint4*)(Y2 + off), zv = *(const uint4*)(Z + off);
      float y[8], z[8];
      y[0] = bflo(yv.x); y[1] = bfhi(yv.x); y[2] = bflo(yv.y); y[3] = bfhi(yv.y); y[4] = bflo(yv.z); y[5] = bfhi(yv.z); y[6] = bflo(yv.w); y[7] = bfhi(yv.w);
      z[0] = bflo(zv.x); z[1] = bfhi(zv.x); z[2] = bflo(zv.y); z[3] = bfhi(zv.y); z[4] = bflo(zv.z); z[5] = bfhi(zv.z); z[6] = bflo(zv.w); z[7] = bfhi(zv.w);
      float ss = 0.f;
#pragma unroll
      for (int e = 0; e < 8; e++) { y[e] = y[e] * z[e] * sigmoidf_(z[e]); ss += y[e] * y[e]; }
      ss = wave_sum(ss);
      const float rstd = rsqrtf(ss * (1.f / 512.f) + 1e-5f);
      const float4 w0 = *(const float4*)(nw + c * 512 + lane * 8), w1 = *(const float4*)(nw + c * 512 + lane * 8 + 4);
      *(uint4*)(YG + off) = make_uint4(cvtpk(y[0] * rstd * w0.x, y[1] * rstd * w0.y), cvtpk(y[2] * rstd * w0.z, y[3] * rstd * w0.w),
                                       cvtpk(y[4] * rstd * w1.x, y[5] * rstd * w1.y), cvtpk(y[6] * rstd * w1.z, y[7] * rstd * w1.w));
    }
  }
}


#define XB_TMO      128
#define XB_XCNT(j)  (256  + 64 * (j))
#define XB_XSUB(j)  (1280 + 64 * (j))
#define XB_XGEN(j)  (2304 + 64 * (j))
#define XB_TOP      3328
#define XB_TOPGEN   3392
#define XCD_BAR_WORDS 3456
#define XB_SPIN_CAP (1u << 20)
#define LAS __attribute__((address_space(3)))
__device__ __forceinline__ unsigned xb_ld(unsigned* p)              { return __hip_atomic_load(p, __ATOMIC_RELAXED, __HIP_MEMORY_SCOPE_AGENT); }
__device__ __forceinline__ unsigned xb_add(unsigned* p, unsigned v) { return __hip_atomic_fetch_add(p, v, __ATOMIC_RELAXED, __HIP_MEMORY_SCOPE_AGENT); }
__device__ __forceinline__ unsigned xb_xcc_id() { return (unsigned)__builtin_amdgcn_s_getreg((3 << 11) | 20) & 0xFu; }
#define XB_SPIN(cond, bar) do { unsigned _sp = 0; while (cond) { __builtin_amdgcn_s_sleep(1); \
    if ((++_sp & 255u) == 0u) { if (xb_ld(&(bar)[XB_TMO])) break; if (_sp > XB_SPIN_CAP) { atomicAdd(&(bar)[XB_TMO], 1u); break; } } } } while (0)
struct XcdBarrier { unsigned* bar; unsigned x; volatile LAS unsigned* st; };
__device__ __forceinline__ XcdBarrier xcd_barrier_post(unsigned* bar, volatile LAS unsigned* st) {
  XcdBarrier b; b.bar = bar; b.x = xb_xcc_id(); b.st = st;
  if (threadIdx.x == 0) (void)xb_add(&bar[XB_XCNT(b.x)], 1u);
  return b;
}
__device__ __forceinline__ void xcd_barrier_complete(unsigned* bar, unsigned x, unsigned& nloc, unsigned& nx) {
  const unsigned G = gridDim.x * gridDim.y * gridDim.z;
  unsigned sum, cnt, mine, sp = 0u;
  for (;;) {
    sum = 0u; cnt = 0u; mine = 0u;
#pragma unroll
    for (unsigned j = 0; j < 16; ++j) { const unsigned c = xb_ld(&bar[XB_XCNT(j)]); sum += c; cnt += (c > 0u) ? 1u : 0u; mine = (j == x) ? c : mine; }
    if (sum == G) break;
    __builtin_amdgcn_s_sleep(1);
    if ((++sp & 255u) == 0u) { if (xb_ld(&bar[XB_TMO])) break; if (sp > XB_SPIN_CAP) { atomicAdd(&bar[XB_TMO], 1u); break; } }
  }
  nloc = mine > 0u ? mine : 1u; nx = cnt > 0u ? cnt : 1u;
}
__device__ __forceinline__ void xcd_barrier(const XcdBarrier& b) {
  asm volatile("s_waitcnt vmcnt(0)" ::: "memory");
  __syncthreads();
  if (threadIdx.x == 0) {
    unsigned* bar = b.bar;
    __builtin_amdgcn_s_waitcnt(0);
    unsigned nloc = b.st[0], nx = b.st[1];
    if (nloc == 0u) { xcd_barrier_complete(bar, b.x, nloc, nx); b.st[0] = nloc; b.st[1] = nx; }
    const unsigned old = xb_add(&bar[XB_XSUB(b.x)], 1u);
    const unsigned gen = old / nloc;
    if (old + 1u == (gen + 1u) * nloc) {
      __builtin_amdgcn_fence(__ATOMIC_RELEASE, "agent");
      asm volatile("s_waitcnt vmcnt(0)" ::: "memory");
      const unsigned og = xb_add(&bar[XB_TOP], 1u);
      const unsigned tg = og / nx;
      if (og + 1u == (tg + 1u) * nx) xb_add(&bar[XB_TOPGEN], 1u);
      else XB_SPIN(xb_ld(&bar[XB_TOPGEN]) == tg, bar);
      __builtin_amdgcn_fence(__ATOMIC_ACQUIRE, "agent");
      xb_add(&bar[XB_XGEN(b.x)], 1u);
      asm volatile("s_waitcnt vmcnt(0)" ::: "memory");
    } else {
      XB_SPIN(xb_ld(&bar[XB_XGEN(b.x)]) == gen, bar);
      __builtin_amdgcn_fence(__ATOMIC_ACQUIRE, "agent");
      asm volatile("s_waitcnt vmcnt(0)" ::: "memory");
    }
  }
  __syncthreads();
}

__global__ void __launch_bounds__(256, 2) fwd_megakernel(Params p) {
  __shared__ __attribute__((aligned(16))) char smem[73728];
  __shared__ uint4 xb_words;
  cg::grid_group grid = cg::this_grid();
  XcdBarrier xb;
  xb.bar = (unsigned*)(p.ws + OFF_BAR); xb.x = 0; xb.st = (volatile LAS unsigned*)&xb_words;
  if (p.phase_hi - p.phase_lo > 1) {
    if (threadIdx.x == 0) xb_words = make_uint4(0u, 0u, 0u, 0u);
    __syncthreads();
    xb = xcd_barrier_post((unsigned*)(p.ws + OFF_BAR), (volatile LAS unsigned*)&xb_words);
  }
#define PHASE(n_, call_)                                   \
  if (p.phase_lo <= (n_) && (n_) < p.phase_hi) {           \
    if ((n_) > p.phase_lo) {                               \
      if (p.phase_lo < 0) grid.sync(); else xcd_barrier(xb); \
    }                                                      \
    call_;                                                 \
  }
  PHASE(0, { if (PROBE & 16) phase0(p, smem); phase0(p, smem); })
  PHASE(1, { if (PROBE & 2) phase_rwkv_proj(p, smem); phase_rwkv_proj(p, smem); })
  PHASE(2, { if (PROBE & 2) phase_rwkv_lora2(p, smem); phase_rwkv_lora2(p, smem); })
  PHASE(3, phase_rwkv_prep(p, smem))
  PHASE(4, { if (PROBE & 64) phase_rwkv_scan(p, smem); phase_rwkv_scan(p, smem); })
  PHASE(5, phase_rwkv_out(p))
  PHASE(6, { if (PROBE & 2) phase_gemm_hadd(p, smem, (const bf16_t*)(p.ws + OFF_Y), DM, (const bf16_t*)(p.ws + WT_WO), 1024, true);
             phase_gemm_hadd(p, smem, (const bf16_t*)(p.ws + OFF_Y), DM, (const bf16_t*)(p.ws + WT_WO), 1024); })
  PHASE(7, { if (PROBE & 32) phase_peer_norm(p, 0); phase_peer_norm(p, 0); })
  PHASE(8, { if (PROBE & 8) phase_peer_query(p, 0, smem); phase_peer_query(p, 0, smem); })
  PHASE(9, phase_peer_route(p, 0))
  PHASE(10, { if (PROBE & 1) phase_peer_expert(p, 0, smem, true); phase_peer_expert(p, 0, smem); })
  PHASE(11, { if (PROBE & 2) phase_mamba_inproj(p, smem); phase_mamba_inproj(p, smem); })
  PHASE(12, phase_mamba_conv(p))
  PHASE(13, { if (PROBE & (4 | 128)) phase_mamba_scan(p, smem); phase_mamba_scan(p, smem); })
  PHASE(14, { if (PROBE & 32) phase_mamba_gate(p); phase_mamba_gate(p); })
  PHASE(15, { if (PROBE & 2) phase_gemm_hadd(p, smem, (const bf16_t*)(p.ws + OFF_YG), 2048, (const bf16_t*)(p.ws + WT_OUT), 2048, true);
              phase_gemm_hadd(p, smem, (const bf16_t*)(p.ws + OFF_YG), 2048, (const bf16_t*)(p.ws + WT_OUT), 2048); })
  PHASE(16, { if (PROBE & 32) phase_peer_norm(p, 1); phase_peer_norm(p, 1); })
  PHASE(17, { if (PROBE & 8) phase_peer_query(p, 1, smem); phase_peer_query(p, 1, smem); })
  PHASE(18, phase_peer_route(p, 1))
  PHASE(19, { if (PROBE & 1) phase_peer_expert(p, 1, smem, true); phase_peer_expert(p, 1, smem); })
}

extern "C" void kernel_launch(void* const* d_in, const int* in_sizes, int n_in, void* d_out, int out_size, void* d_ws,
                              size_t ws_size, hipStream_t stream) {
  static int grid_blocks = 0;
  if (!grid_blocks) {
    int dev = 0, cus = 0, per_cu = 0;
    (void)hipGetDevice(&dev);
    (void)hipDeviceGetAttribute(&cus, hipDeviceAttributeMultiprocessorCount, dev);
    (void)hipOccupancyMaxActiveBlocksPerMultiprocessor(&per_cu, fwd_megakernel, 256, 0);
    if (per_cu < 1) per_cu = 1;
    if (per_cu > 2) per_cu = 2;
    grid_blocks = cus * per_cu;
  }
  if (ws_size < WS_NEED) { fprintf(stderr, "workspace too small: %zu < %zu\n", ws_size, (size_t)WS_NEED); return; }
  Params p{};
  for (int i = 0; i < 38; i++) p.in[i] = (const float*)d_in[i];
  p.out = (float*)d_out;
  p.ws = (char*)d_ws;
#if MK_MULTI
  for (int ph = 0; ph < NPHASE; ph++) {
    p.phase_lo = ph; p.phase_hi = ph + 1;
    hipLaunchKernelGGL(fwd_megakernel, dim3(grid_blocks), dim3(256), 0, stream, p);
  }
#else
  p.phase_lo = 0; p.phase_hi = NPHASE;
  (void)hipMemsetAsync((char*)d_ws + OFF_BAR, 0, 16384, stream);
  void* args[] = {&p};
  hipError_t e = hipLaunchCooperativeKernel((void*)fwd_megakernel, dim3(grid_blocks), dim3(256), args, 0, stream);
  if (e != hipSuccess) fprintf(stderr, "cooperative launch failed: %s (grid %d)\n", hipGetErrorString(e), grid_blocks);
#endif
}
```

```cpp
#include <hip/hip_runtime.h>
#include <hip/hip_cooperative_groups.h>
#include <stdint.h>
#include <stdio.h>
namespace cg = cooperative_groups;

#ifndef PROBE
#define PROBE 0
#endif
#ifndef MK_MULTI
#define MK_MULTI 0
#endif

typedef unsigned short bf16_t;
typedef short bf16x8 __attribute__((ext_vector_type(8)));
typedef float f32x16 __attribute__((ext_vector_type(16)));
typedef float f32x2_t __attribute__((ext_vector_type(2)));
typedef __bf16 bf16x2_t __attribute__((ext_vector_type(2)));

#define DM 1024
#define LP 2064
#define TP 16512
#define TS 512
#define TT 17024
#define NPHASE 20

#define OUT0 0
#define OUT1 16777216
#define OUT2 17301504
#define OUT3 17309696
#define OUT4 17833984
#define OUT5 17907712
#define OUT6 20004864
#define OUT7 20135936
#define OUT8 28524544
#define OUT9 29704192

constexpr size_t UB = 34865152ull;
constexpr size_t OFF_H = 0;
constexpr size_t OFF_TAB = OFF_H + 2 * UB;
constexpr size_t OFF_WT = OFF_TAB + 67108864ull;
constexpr size_t WT_RKV = OFF_WT;
constexpr size_t WT_W1 = WT_RKV + 6291456;
constexpr size_t WT_A1 = WT_W1 + 131072;
constexpr size_t WT_G1 = WT_A1 + 131072;
constexpr size_t WT_W2 = WT_G1 + 393216;
constexpr size_t WT_A2 = WT_W2 + 131072;
constexpr size_t WT_G2 = WT_A2 + 131072;
constexpr size_t WT_WO = WT_G2 + 393216;
constexpr size_t WT_IN = WT_WO + 2097152;
constexpr size_t WT_OUT = WT_IN + 10551296;
constexpr size_t WT_Q = WT_OUT + 4194304;
constexpr size_t WT_SK = WT_Q + 8388608;
constexpr size_t WT_SH0 = WT_SK + 1048576;
constexpr size_t WT_ZERO = WT_SH0 + 262144;
constexpr size_t WT_SC = WT_ZERO + 2048;
constexpr size_t OFF_ARENA = OFF_WT + 34603008ull;
constexpr size_t RG(int i) { return OFF_ARENA + (size_t)i * UB; }
constexpr size_t OFF_L1W = RG(8);
constexpr size_t OFF_L1A = OFF_L1W + 2179072;
constexpr size_t OFF_L1G = OFF_L1A + 2179072;
constexpr size_t OFF_DTR = OFF_L1G + 6537216;
constexpr size_t OFF_BAR = OFF_DTR + 2179072;
constexpr size_t OFF_BON = OFF_BAR + 16384;
constexpr size_t OFF_BB = OFF_BON + 1089536;
constexpr size_t OFF_XC = OFF_BB;
constexpr size_t OFF_RSM = OFF_BB + UB;
constexpr size_t RSM_ITEM = 2304;
constexpr size_t OFF_RSP = OFF_RSM + 18560 * RSM_ITEM;
constexpr size_t WS_NEED = OFF_BB + 3 * UB;
static_assert(OFF_RSP + 2048ull * 10240 <= OFF_BB + 3 * UB, "rwkv packed region");
constexpr size_t OFF_XN = RG(0);
constexpr size_t OFF_Y = RG(0);
constexpr size_t OFF_R = RG(1), OFF_K = RG(2), OFF_V = RG(3);
constexpr size_t OFF_DEC = RG(4);
constexpr size_t OFF_A = RG(6), OFF_G = RG(7);
constexpr size_t OFF_XN2_0 = RG(1);
constexpr size_t OFF_KEYS_0 = RG(2);
constexpr size_t OFF_XNM = RG(0);
constexpr size_t OFF_Z = RG(1);
constexpr size_t OFF_XBC = RG(3);
constexpr size_t OFF_Y2 = RG(6);
constexpr size_t OFF_YG = RG(3);
constexpr size_t OFF_XN2_1 = RG(5);
constexpr size_t OFF_KEYS_1 = RG(0);

struct Params {
  const float* in[38];
  float* out;
  char* ws;
  int phase_lo, phase_hi;
};

__device__ __forceinline__ unsigned cvtpk(float lo, float hi) {
  f32x2_t v = {lo, hi};
  bf16x2_t b = __builtin_convertvector(v, bf16x2_t);
  return __builtin_bit_cast(unsigned, b);
}
__device__ __forceinline__ float bflo(unsigned u) { return __uint_as_float(u << 16); }
__device__ __forceinline__ float bfhi(unsigned u) { return __uint_as_float(u & 0xffff0000u); }
__device__ __forceinline__ float bf2f(bf16_t b) { return __uint_as_float(((unsigned)b) << 16); }
__device__ __forceinline__ bf16_t f2bf(float f) { return (bf16_t)(cvtpk(f, 0.f) & 0xffffu); }
__device__ __forceinline__ float dot2bf(unsigned a, unsigned b, float c) {
  return __builtin_amdgcn_fdot2_f32_bf16(__builtin_bit_cast(bf16x2_t, a), __builtin_bit_cast(bf16x2_t, b), c, false);
}
template <int CTRL> __device__ __forceinline__ float dpp_f(float v) {
  return __int_as_float(__builtin_amdgcn_update_dpp(0, __float_as_int(v), CTRL, 0xf, 0xf, true));
}
template <int CTRL> __device__ __forceinline__ int dpp_i(int v) {
  return __builtin_amdgcn_update_dpp(0, v, CTRL, 0xf, 0xf, true);
}
__device__ __forceinline__ float quad_sum(float v) { v += dpp_f<0xB1>(v); v += dpp_f<0x4E>(v); return v; }
__device__ __forceinline__ float oct_sum(float v) { v = quad_sum(v); v += dpp_f<0x141>(v); return v; }
__device__ __forceinline__ float row_sum(float v) { v = oct_sum(v); v += dpp_f<0x140>(v); return v; }
__device__ __forceinline__ float rdlane(float v, int l) { return __int_as_float(__builtin_amdgcn_readlane(__float_as_int(v), l)); }
__device__ __forceinline__ float wave_sum(float v) {
  v = row_sum(v);
  return (rdlane(v, 0) + rdlane(v, 16)) + (rdlane(v, 32) + rdlane(v, 48));
}
__device__ __forceinline__ float wave_max(float v) {
  v = fmaxf(v, dpp_f<0xB1>(v)); v = fmaxf(v, dpp_f<0x4E>(v)); v = fmaxf(v, dpp_f<0x141>(v)); v = fmaxf(v, dpp_f<0x140>(v));
  return fmaxf(fmaxf(rdlane(v, 0), rdlane(v, 16)), fmaxf(rdlane(v, 32), rdlane(v, 48)));
}
__device__ __forceinline__ float sigmoidf_(float x) { return 1.f / (1.f + __expf(-x)); }
__device__ __forceinline__ float softplusf_(float x) { return fmaxf(x, 0.f) + log1pf(__expf(-fabsf(x))); }
__device__ __forceinline__ int enc_key(float s) { int i = __float_as_int(s); return i ^ ((i >> 31) & 0x7fffffff); }
__device__ __forceinline__ float dec_key(int i) { return __int_as_float(i ^ ((i >> 31) & 0x7fffffff)); }

__device__ __forceinline__ void unpack8(const uint4 u, float (&f)[8]) {
  f[0] = bflo(u.x); f[1] = bfhi(u.x); f[2] = bflo(u.y); f[3] = bfhi(u.y); f[4] = bflo(u.z); f[5] = bfhi(u.z); f[6] = bflo(u.w); f[7] = bfhi(u.w);
}
__device__ __forceinline__ uint4 pack8(const float (&f)[8]) {
  return make_uint4(cvtpk(f[0], f[1]), cvtpk(f[2], f[3]), cvtpk(f[4], f[5]), cvtpk(f[6], f[7]));
}
#define INS16(L, x_)                          \
  {                                           \
    int xx = (x_);                            \
    _Pragma("unroll") for (int q_ = 0; q_ < 16; q_++) { \
      int hi_ = max(L[q_], xx);               \
      xx = min(L[q_], xx);                    \
      L[q_] = hi_;                            \
    }                                         \
  }

__device__ __forceinline__ void sort16_desc(int (&a)[16]) {
  { const int hi_ = max(a[0], a[1]), lo_ = min(a[0], a[1]); a[0] = hi_; a[1] = lo_; }
  { const int hi_ = max(a[2], a[3]), lo_ = min(a[2], a[3]); a[2] = lo_; a[3] = hi_; }
  { const int hi_ = max(a[4], a[5]), lo_ = min(a[4], a[5]); a[4] = hi_; a[5] = lo_; }
  { const int hi_ = max(a[6], a[7]), lo_ = min(a[6], a[7]); a[6] = lo_; a[7] = hi_; }
  { const int hi_ = max(a[8], a[9]), lo_ = min(a[8], a[9]); a[8] = hi_; a[9] = lo_; }
  { const int hi_ = max(a[10], a[11]), lo_ = min(a[10], a[11]); a[10] = lo_; a[11] = hi_; }
  { const int hi_ = max(a[12], a[13]), lo_ = min(a[12], a[13]); a[12] = hi_; a[13] = lo_; }
  { const int hi_ = max(a[14], a[15]), lo_ = min(a[14], a[15]); a[14] = lo_; a[15] = hi_; }
  { const int hi_ = max(a[0], a[2]), lo_ = min(a[0], a[2]); a[0] = hi_; a[2] = lo_; }
  { const int hi_ = max(a[1], a[3]), lo_ = min(a[1], a[3]); a[1] = hi_; a[3] = lo_; }
  { const int hi_ = max(a[4], a[6]), lo_ = min(a[4], a[6]); a[4] = lo_; a[6] = hi_; }
  { const int hi_ = max(a[5], a[7]), lo_ = min(a[5], a[7]); a[5] = lo_; a[7] = hi_; }
  { const int hi_ = max(a[8], a[10]), lo_ = min(a[8], a[10]); a[8] = hi_; a[10] = lo_; }
  { const int hi_ = max(a[9], a[11]), lo_ = min(a[9], a[11]); a[9] = hi_; a[11] = lo_; }
  { const int hi_ = max(a[12], a[14]), lo_ = min(a[12], a[14]); a[12] = lo_; a[14] = hi_; }
  { const int hi_ = max(a[13], a[15]), lo_ = min(a[13], a[15]); a[13] = lo_; a[15] = hi_; }
  { const int hi_ = max(a[0], a[1]), lo_ = min(a[0], a[1]); a[0] = hi_; a[1] = lo_; }
  { const int hi_ = max(a[2], a[3]), lo_ = min(a[2], a[3]); a[2] = hi_; a[3] = lo_; }
  { const int hi_ = max(a[4], a[5]), lo_ = min(a[4], a[5]); a[4] = lo_; a[5] = hi_; }
  { const int hi_ = max(a[6], a[7]), lo_ = min(a[6], a[7]); a[6] = lo_; a[7] = hi_; }
  { const int hi_ = max(a[8], a[9]), lo_ = min(a[8], a[9]); a[8] = hi_; a[9] = lo_; }
  { const int hi_ = max(a[10], a[11]), lo_ = min(a[10], a[11]); a[10] = hi_; a[11] = lo_; }
  { const int hi_ = max(a[12], a[13]), lo_ = min(a[12], a[13]); a[12] = lo_; a[13] = hi_; }
  { const int hi_ = max(a[14], a[15]), lo_ = min(a[14], a[15]); a[14] = lo_; a[15] = hi_; }
  { const int hi_ = max(a[0], a[4]), lo_ = min(a[0], a[4]); a[0] = hi_; a[4] = lo_; }
  { const int hi_ = max(a[1], a[5]), lo_ = min(a[1], a[5]); a[1] = hi_; a[5] = lo_; }
  { const int hi_ = max(a[2], a[6]), lo_ = min(a[2], a[6]); a[2] = hi_; a[6] = lo_; }
  { const int hi_ = max(a[3], a[7]), lo_ = min(a[3], a[7]); a[3] = hi_; a[7] = lo_; }
  { const int hi_ = max(a[8], a[12]), lo_ = min(a[8], a[12]); a[8] = lo_; a[12] = hi_; }
  { const int hi_ = max(a[9], a[13]), lo_ = min(a[9], a[13]); a[9] = lo_; a[13] = hi_; }
  { const int hi_ = max(a[10], a[14]), lo_ = min(a[10], a[14]); a[10] = lo_; a[14] = hi_; }
  { const int hi_ = max(a[11], a[15]), lo_ = min(a[11], a[15]); a[11] = lo_; a[15] = hi_; }
  { const int hi_ = max(a[0], a[2]), lo_ = min(a[0], a[2]); a[0] = hi_; a[2] = lo_; }
  { const int hi_ = max(a[1], a[3]), lo_ = min(a[1], a[3]); a[1] = hi_; a[3] = lo_; }
  { const int hi_ = max(a[4], a[6]), lo_ = min(a[4], a[6]); a[4] = hi_; a[6] = lo_; }
  { const int hi_ = max(a[5], a[7]), lo_ = min(a[5], a[7]); a[5] = hi_; a[7] = lo_; }
  { const int hi_ = max(a[8], a[10]), lo_ = min(a[8], a[10]); a[8] = lo_; a[10] = hi_; }
  { const int hi_ = max(a[9], a[11]), lo_ = min(a[9], a[11]); a[9] = lo_; a[11] = hi_; }
  { const int hi_ = max(a[12], a[14]), lo_ = min(a[12], a[14]); a[12] = lo_; a[14] = hi_; }
  { const int hi_ = max(a[13], a[15]), lo_ = min(a[13], a[15]); a[13] = lo_; a[15] = hi_; }
  { const int hi_ = max(a[0], a[1]), lo_ = min(a[0], a[1]); a[0] = hi_; a[1] = lo_; }
  { const int hi_ = max(a[2], a[3]), lo_ = min(a[2], a[3]); a[2] = hi_; a[3] = lo_; }
  { const int hi_ = max(a[4], a[5]), lo_ = min(a[4], a[5]); a[4] = hi_; a[5] = lo_; }
  { const int hi_ = max(a[6], a[7]), lo_ = min(a[6], a[7]); a[6] = hi_; a[7] = lo_; }
  { const int hi_ = max(a[8], a[9]), lo_ = min(a[8], a[9]); a[8] = lo_; a[9] = hi_; }
  { const int hi_ = max(a[10], a[11]), lo_ = min(a[10], a[11]); a[10] = lo_; a[11] = hi_; }
  { const int hi_ = max(a[12], a[13]), lo_ = min(a[12], a[13]); a[12] = lo_; a[13] = hi_; }
  { const int hi_ = max(a[14], a[15]), lo_ = min(a[14], a[15]); a[14] = lo_; a[15] = hi_; }
  { const int hi_ = max(a[0], a[8]), lo_ = min(a[0], a[8]); a[0] = hi_; a[8] = lo_; }
  { const int hi_ = max(a[1], a[9]), lo_ = min(a[1], a[9]); a[1] = hi_; a[9] = lo_; }
  { const int hi_ = max(a[2], a[10]), lo_ = min(a[2], a[10]); a[2] = hi_; a[10] = lo_; }
  { const int hi_ = max(a[3], a[11]), lo_ = min(a[3], a[11]); a[3] = hi_; a[11] = lo_; }
  { const int hi_ = max(a[4], a[12]), lo_ = min(a[4], a[12]); a[4] = hi_; a[12] = lo_; }
  { const int hi_ = max(a[5], a[13]), lo_ = min(a[5], a[13]); a[5] = hi_; a[13] = lo_; }
  { const int hi_ = max(a[6], a[14]), lo_ = min(a[6], a[14]); a[6] = hi_; a[14] = lo_; }
  { const int hi_ = max(a[7], a[15]), lo_ = min(a[7], a[15]); a[7] = hi_; a[15] = lo_; }
  { const int hi_ = max(a[0], a[4]), lo_ = min(a[0], a[4]); a[0] = hi_; a[4] = lo_; }
  { const int hi_ = max(a[1], a[5]), lo_ = min(a[1], a[5]); a[1] = hi_; a[5] = lo_; }
  { const int hi_ = max(a[2], a[6]), lo_ = min(a[2], a[6]); a[2] = hi_; a[6] = lo_; }
  { const int hi_ = max(a[3], a[7]), lo_ = min(a[3], a[7]); a[3] = hi_; a[7] = lo_; }
  { const int hi_ = max(a[8], a[12]), lo_ = min(a[8], a[12]); a[8] = hi_; a[12] = lo_; }
  { const int hi_ = max(a[9], a[13]), lo_ = min(a[9], a[13]); a[9] = hi_; a[13] = lo_; }
  { const int hi_ = max(a[10], a[14]), lo_ = min(a[10], a[14]); a[10] = hi_; a[14] = lo_; }
  { const int hi_ = max(a[11], a[15]), lo_ = min(a[11], a[15]); a[11] = hi_; a[15] = lo_; }
  { const int hi_ = max(a[0], a[2]), lo_ = min(a[0], a[2]); a[0] = hi_; a[2] = lo_; }
  { const int hi_ = max(a[1], a[3]), lo_ = min(a[1], a[3]); a[1] = hi_; a[3] = lo_; }
  { const int hi_ = max(a[4], a[6]), lo_ = min(a[4], a[6]); a[4] = hi_; a[6] = lo_; }
  { const int hi_ = max(a[5], a[7]), lo_ = min(a[5], a[7]); a[5] = hi_; a[7] = lo_; }
  { const int hi_ = max(a[8], a[10]), lo_ = min(a[8], a[10]); a[8] = hi_; a[10] = lo_; }
  { const int hi_ = max(a[9], a[11]), lo_ = min(a[9], a[11]); a[9] = hi_; a[11] = lo_; }
  { const int hi_ = max(a[12], a[14]), lo_ = min(a[12], a[14]); a[12] = hi_; a[14] = lo_; }
  { const int hi_ = max(a[13], a[15]), lo_ = min(a[13], a[15]); a[13] = hi_; a[15] = lo_; }
  { const int hi_ = max(a[0], a[1]), lo_ = min(a[0], a[1]); a[0] = hi_; a[1] = lo_; }
  { const int hi_ = max(a[2], a[3]), lo_ = min(a[2], a[3]); a[2] = hi_; a[3] = lo_; }
  { const int hi_ = max(a[4], a[5]), lo_ = min(a[4], a[5]); a[4] = hi_; a[5] = lo_; }
  { const int hi_ = max(a[6], a[7]), lo_ = min(a[6], a[7]); a[6] = hi_; a[7] = lo_; }
  { const int hi_ = max(a[8], a[9]), lo_ = min(a[8], a[9]); a[8] = hi_; a[9] = lo_; }
  { const int hi_ = max(a[10], a[11]), lo_ = min(a[10], a[11]); a[10] = hi_; a[11] = lo_; }
  { const int hi_ = max(a[12], a[13]), lo_ = min(a[12], a[13]); a[12] = hi_; a[13] = lo_; }
  { const int hi_ = max(a[14], a[15]), lo_ = min(a[14], a[15]); a[14] = hi_; a[15] = lo_; }
}
__device__ __forceinline__ void merge16_desc(int (&L)[16], const int (&b)[16]) {
#pragma unroll
  for (int j = 0; j < 16; j++) L[j] = max(L[j], b[15 - j]);
#define MSTAGE(d_)                                                                                          \
  _Pragma("unroll") for (int j = 0; j < 16; j++) if ((j & (d_)) == 0) {                                    \
    const int hi = max(L[j], L[j + (d_)]), lo = min(L[j], L[j + (d_)]); L[j] = hi; L[j + (d_)] = lo; }
  MSTAGE(8) MSTAGE(4) MSTAGE(2) MSTAGE(1)
#undef MSTAGE
}

__device__ __forceinline__ void transpose_job(const float* __restrict__ src, int K, int N, bf16_t* __restrict__ dst, int ldk,
                              int nrows, float* tile, int rot, int vb = -1, int vnb = 0) {
  const int tid = threadIdx.x;
  const int tk = ldk / 64, tn = (nrows + 63) / 64;
  const int nb = (vb < 0) ? (int)gridDim.x : vnb;
  const int bid = (((vb < 0) ? (int)blockIdx.x : vb) + rot) % nb;
  for (int tix = bid; tix < tk * tn; tix += nb) {
    const int k0 = (tix % tk) * 64, n0 = (tix / tk) * 64;
#pragma unroll
    for (int i = 0; i < 4; i++) {
      const int kl = (tid >> 4) + 16 * i, nl = (tid & 15) * 4;
      const int k = k0 + kl, n = n0 + nl;
      float4 v = make_float4(0.f, 0.f, 0.f, 0.f);
      if (k < K && n < N) v = *(const float4*)(src + (size_t)k * N + n);
      float* tp = tile + kl * 65 + nl;
      tp[0] = v.x; tp[1] = v.y; tp[2] = v.z; tp[3] = v.w;
    }
    __syncthreads();
    {
      const int nl = tid >> 2, kq = tid & 3;
      const int n = n0 + nl;
      if (n < nrows) {
        unsigned w[8];
#pragma unroll
        for (int j = 0; j < 8; j++)
          w[j] = cvtpk(tile[(kq * 16 + 2 * j) * 65 + nl], tile[(kq * 16 + 2 * j + 1) * 65 + nl]);
        uint4* dp = (uint4*)(dst + (size_t)n * ldk + k0 + kq * 16);
        dp[0] = make_uint4(w[0], w[1], w[2], w[3]);
        dp[1] = make_uint4(w[4], w[5], w[6], w[7]);
      }
    }
    __syncthreads();
  }
}

__device__ __forceinline__ void convert_linear(const float* __restrict__ src, bf16_t* __restrict__ dst, size_t n8, bool nt, int vb = -1, int vnb = 0) {
  typedef float f32x4n __attribute__((ext_vector_type(4)));
  const f32x4n* s = (const f32x4n*)src;
  uint4* d = (uint4*)dst;
  const size_t stride = (size_t)((vb < 0) ? (int)gridDim.x : vnb) * 256;
  for (size_t i = (size_t)((vb < 0) ? (int)blockIdx.x : vb) * 256 + threadIdx.x; i < n8; i += stride) {
    f32x4n a, b;
    if (nt) {
      a = __builtin_nontemporal_load(s + 2 * i);
      b = __builtin_nontemporal_load(s + 2 * i + 1);
    } else {
      a = s[2 * i]; b = s[2 * i + 1];
    }
    d[i] = make_uint4(cvtpk(a.x, a.y), cvtpk(a.z, a.w), cvtpk(b.x, b.y), cvtpk(b.z, b.w));
  }
}

__device__ __forceinline__ void convert_tables_fp8(const Params& p, int vb, int vnb, int layer) {
  typedef float f32x4n __attribute__((ext_vector_type(4)));
  const int lane = threadIdx.x & 63, wave = threadIdx.x >> 6;
  uint2* tab = (uint2*)(p.ws + OFF_TAB);
  float* sc = (float*)(p.ws + WT_SC);
  for (int r = layer * 32768 + vb * 4 + wave; r < (layer + 1) * 32768; r += vnb * 4) {
    const int which = r >> 14, row = r & 16383;
    const float* src = ((which & 1) ? p.in[37] : p.in[36]) + (size_t)(which >> 1) * 16777216 + (size_t)row * 1024;
    f32x4n v[4]; float am = 0.f;
#pragma unroll
    for (int i = 0; i < 4; i++) {
      v[i] = __builtin_nontemporal_load((const f32x4n*)src + lane * 4 + i);
      am = fmaxf(am, fmaxf(fmaxf(fabsf(v[i].x), fabsf(v[i].y)), fmaxf(fabsf(v[i].z), fabsf(v[i].w))));
    }
    am = wave_max(am);
    const float scale = am > 0.f ? 6.f / am : 0.f;
    unsigned w0 = 0, w1 = 0;
    w0 = __builtin_amdgcn_cvt_scalef32_pk_fp4_f32(w0, v[0].x * scale, v[0].y * scale, 1.0f, 0);
    w0 = __builtin_amdgcn_cvt_scalef32_pk_fp4_f32(w0, v[0].z * scale, v[0].w * scale, 1.0f, 1);
    w0 = __builtin_amdgcn_cvt_scalef32_pk_fp4_f32(w0, v[1].x * scale, v[1].y * scale, 1.0f, 2);
    w0 = __builtin_amdgcn_cvt_scalef32_pk_fp4_f32(w0, v[1].z * scale, v[1].w * scale, 1.0f, 3);
    w1 = __builtin_amdgcn_cvt_scalef32_pk_fp4_f32(w1, v[2].x * scale, v[2].y * scale, 1.0f, 0);
    w1 = __builtin_amdgcn_cvt_scalef32_pk_fp4_f32(w1, v[2].z * scale, v[2].w * scale, 1.0f, 1);
    w1 = __builtin_amdgcn_cvt_scalef32_pk_fp4_f32(w1, v[3].x * scale, v[3].y * scale, 1.0f, 2);
    w1 = __builtin_amdgcn_cvt_scalef32_pk_fp4_f32(w1, v[3].z * scale, v[3].w * scale, 1.0f, 3);
    tab[(size_t)r * 64 + lane] = make_uint2(w0, w1);
    if (lane == 0) sc[r] = am * (1.f / 6.f);
  }
}

__device__ __forceinline__ void phase0(const Params& p, char* smem) {
  const int tid = threadIdx.x, lane = tid & 63, wave = tid >> 6;
  const int nb = gridDim.x, bid = blockIdx.x;
  {
    float* H = (float*)(p.ws + OFF_H);
    bf16_t* XN = (bf16_t*)(p.ws + OFF_XN);
    const float4* g0 = (const float4*)p.in[7];
    for (int t = bid * 4 + wave; t < TT; t += nb * 4) {
      const float* src; int b, l;
      if (t < TP) {
        b = t / LP; l = t - b * LP;
        src = (l < 16) ? (p.in[6] + l * DM) : (p.in[0] + ((size_t)b * 2048 + (l - 16)) * DM);
      } else {
        int s = t - TP; b = s >> 2; l = s & 3; src = p.in[1] + (size_t)s * DM;
      }
      float4 v[4]; float ss = 0.f;
#pragma unroll
      for (int i = 0; i < 4; i++) {
        v[i] = ((const float4*)src)[i * 64 + lane];
        ss += v[i].x * v[i].x + v[i].y * v[i].y + v[i].z * v[i].z + v[i].w * v[i].w;
      }
      ss = wave_sum(ss);
      const float rstd = rsqrtf(ss * (1.f / 1024.f) + 1e-5f);
      float* sdst = nullptr;
      if (t < TP) { if (l == LP - 1) sdst = p.out + OUT2 + b * DM; }
      else if (l == 3) sdst = p.out + OUT6 + b * DM;
#pragma unroll
      for (int i = 0; i < 4; i++) {
        const float4 g = g0[i * 64 + lane];
        ((float4*)(H + (size_t)t * DM))[i * 64 + lane] = v[i];
        float4 xn = make_float4(v[i].x * rstd * g.x, v[i].y * rstd * g.y, v[i].z * rstd * g.z, v[i].w * rstd * g.w);
        ((uint2*)(XN + (size_t)t * DM))[i * 64 + lane] = make_uint2(cvtpk(xn.x, xn.y), cvtpk(xn.z, xn.w));
        if (sdst) ((float4*)sdst)[i * 64 + lane] = xn;
      }
    }
  }
  float* tile = (float*)smem;
  char* ws = p.ws;
  for (int j = 0; j < 3; j++)
    transpose_job(p.in[11] + (size_t)j * 1048576, 1024, 1024, (bf16_t*)(ws + WT_RKV) + (size_t)j * 1048576, 1024, 1024, tile, j * 37);
  transpose_job(p.in[13], 1024, 64, (bf16_t*)(ws + WT_W1), 1024, 64, tile, 11);
  transpose_job(p.in[16], 1024, 64, (bf16_t*)(ws + WT_A1), 1024, 64, tile, 29);
  transpose_job(p.in[18], 1024, 160, (bf16_t*)(ws + WT_G1), 1024, 192, tile, 47);
  transpose_job(p.in[14], 64, 1024, (bf16_t*)(ws + WT_W2), 64, 1024, tile, 95);
  transpose_job(p.in[17], 64, 1024, (bf16_t*)(ws + WT_A2), 64, 1024, tile, 111);
  transpose_job(p.in[19], 160, 1024, (bf16_t*)(ws + WT_G2), 192, 1024, tile, 127);

  convert_linear(p.in[2], (bf16_t*)(ws + WT_SH0), 16384, false);
  if (bid == nb - 1 && tid < 128) ((uint4*)(ws + WT_ZERO))[tid] = make_uint4(0, 0, 0, 0);
}

#define SAS 72
struct GemmA {
  const bf16_t* A; int lda;
  const float* mix; const bf16_t* sh0; const bf16_t* zero;
};

template <int MIX, int SWAP = 0>
__device__ __forceinline__ void gemm_mainloop(f32x16 (&acc)[2][2], const GemmA& ga, const bf16_t* __restrict__ Bt,
                                              int ldb, int Nvalid, int K, int m0, int n0, bf16_t* sA, bf16_t* sB) {
  const int tid = threadIdx.x, lane = tid & 63, wave = tid >> 6;
  const int wm = wave >> 1, wn = wave & 1;
  const int lrow = tid >> 3, kc = tid & 7;
#pragma unroll
  for (int i = 0; i < 2; i++)
#pragma unroll
    for (int j = 0; j < 2; j++)
#pragma unroll
      for (int r = 0; r < 16; r++) acc[i][j][r] = 0.f;
  const bf16_t* arow[4]; const bf16_t* prow[4]; const bf16_t* brow[4]; bool bval[4];
#pragma unroll
  for (int i = 0; i < 4; i++) {
    const int t = m0 + lrow + 32 * i;
    arow[i] = ga.A + (size_t)t * ga.lda + kc * 8;
    prow[i] = arow[i];
    if (MIX) {
      int b, l;
      if (t < TP) { b = t / LP; l = t - b * LP; } else { int s = t - TP; b = s >> 2; l = s & 3; }
      const bf16_t* pr = (l == 0) ? ((t < TP) ? ga.zero : (ga.sh0 + b * DM)) : (ga.A + (size_t)(t - 1) * ga.lda);
      prow[i] = pr + kc * 8;
    }
    const int n = n0 + lrow + 32 * i;
    bval[i] = n < Nvalid;
    brow[i] = Bt + (size_t)(bval[i] ? n : 0) * ldb + kc * 8;
  }
  uint4 rx0[4], rp0[4], rb0[4], rx1[4], rp1[4], rb1[4];
#define GLOAD(RX, RP, RB, k0_)                                                      \
  {                                                                                 \
    _Pragma("unroll") for (int i = 0; i < 4; i++) {                                 \
      RX[i] = *(const uint4*)(arow[i] + (k0_));                                     \
      if (MIX) RP[i] = *(const uint4*)(prow[i] + (k0_));                            \
      RB[i] = bval[i] ? *(const uint4*)(brow[i] + (k0_)) : make_uint4(0, 0, 0, 0);  \
    }                                                                               \
  }
#define GSTORE(RX, RP, RB, k0_, dA_, dB_)                                           \
  {                                                                                 \
    float4 MA, MB;                                                                  \
    if (MIX) { MA = *(const float4*)(ga.mix + (k0_) + kc * 8); MB = *(const float4*)(ga.mix + (k0_) + kc * 8 + 4); } \
    _Pragma("unroll") for (int i = 0; i < 4; i++) {                                 \
      uint4 v = RX[i];                                                              \
      if (MIX) {                                                                    \
        const uint4 x = RX[i], q = RP[i];                                           \
        float xl, xh, pl, ph;                                                       \
        xl = bflo(x.x); xh = bfhi(x.x); pl = bflo(q.x); ph = bfhi(q.x);             \
        v.x = cvtpk(xl + (pl - xl) * MA.x, xh + (ph - xh) * MA.y);                  \
        xl = bflo(x.y); xh = bfhi(x.y); pl = bflo(q.y); ph = bfhi(q.y);             \
        v.y = cvtpk(xl + (pl - xl) * MA.z, xh + (ph - xh) * MA.w);                  \
        xl = bflo(x.z); xh = bfhi(x.z); pl = bflo(q.z); ph = bfhi(q.z);             \
        v.z = cvtpk(xl + (pl - xl) * MB.x, xh + (ph - xh) * MB.y);                  \
        xl = bflo(x.w); xh = bfhi(x.w); pl = bflo(q.w); ph = bfhi(q.w);             \
        v.w = cvtpk(xl + (pl - xl) * MB.z, xh + (ph - xh) * MB.w);                  \
      }                                                                             \
      *(uint4*)((dA_) + (lrow + 32 * i) * SAS + kc * 8) = v;                        \
      *(uint4*)((dB_) + (lrow + 32 * i) * SAS + kc * 8) = RB[i];                    \
    }                                                                               \
  }
#define GCOMPUTE(cA_, cB_)                                                          \
  {                                                                                 \
    _Pragma("unroll") for (int ks = 0; ks < 4; ks++) {                              \
      bf16x8 a[2], b[2];                                                            \
      _Pragma("unroll") for (int i = 0; i < 2; i++) {                               \
        a[i] = *(const bf16x8*)((cA_) + (wm * 64 + i * 32 + (lane & 31)) * SAS + ks * 16 + (lane >> 5) * 8); \
        b[i] = *(const bf16x8*)((cB_) + (wn * 64 + i * 32 + (lane & 31)) * SAS + ks * 16 + (lane >> 5) * 8); \
      }                                                                             \
      _Pragma("unroll") for (int i = 0; i < 2; i++)                                 \
        _Pragma("unroll") for (int j = 0; j < 2; j++)                               \
          acc[i][j] = SWAP ? __builtin_amdgcn_mfma_f32_32x32x16_bf16(b[j], a[i], acc[i][j], 0, 0, 0) \
                           : __builtin_amdgcn_mfma_f32_32x32x16_bf16(a[i], b[j], acc[i][j], 0, 0, 0); \
    }                                                                               \
  }
  bf16_t* A0 = sA; bf16_t* B0 = sA + 128 * SAS;
  bf16_t* A1 = sA + 2 * 128 * SAS; bf16_t* B1 = A1 + 128 * SAS;
  const int nk = K >> 6;
  __syncthreads();
  GLOAD(rx0, rp0, rb0, 0);
  if (nk > 1) GLOAD(rx1, rp1, rb1, 64);
  GSTORE(rx0, rp0, rb0, 0, A0, B0);
  if (nk > 2) GLOAD(rx0, rp0, rb0, 128);
  __syncthreads();
  for (int t = 0; t < nk; t += 2) {
    if (t + 1 < nk) {
      GSTORE(rx1, rp1, rb1, (t + 1) * 64, A1, B1);
      if (t + 3 < nk) GLOAD(rx1, rp1, rb1, (t + 3) * 64);
    }
    GCOMPUTE(A0, B0);
    __syncthreads();
    if (t + 1 < nk) {
      if (t + 2 < nk) {
        GSTORE(rx0, rp0, rb0, (t + 2) * 64, A0, B0);
        if (t + 4 < nk) GLOAD(rx0, rp0, rb0, (t + 4) * 64);
      }
      GCOMPUTE(A1, B1);
      __syncthreads();
    }
  }
#undef GLOAD
#undef GSTORE
#undef GCOMPUTE
}

template <class F>
__device__ __forceinline__ void gemm_epilogue(const f32x16 (&acc)[2][2], int m0, int n0, F f) {
  const int tid = threadIdx.x, lane = tid & 63, wave = tid >> 6;
  const int wm = wave >> 1, wn = wave & 1;
#pragma unroll
  for (int i = 0; i < 2; i++)
#pragma unroll
    for (int j = 0; j < 2; j++)
#pragma unroll
      for (int r = 0; r < 16; r++) {
        const int row = m0 + wm * 64 + i * 32 + (lane >> 5) * 4 + (r & 3) + 8 * (r >> 2);
        const int col = n0 + wn * 64 + j * 32 + (lane & 31);
        f(row, col, acc[i][j][r]);
      }
}

template <class F>
__device__ __forceinline__ void gemm_epilogue_bf16_lds(const f32x16 (&acc)[2][2], bf16_t* __restrict__ out, size_t ld, int m0, int c0,
                                                       int ctile0, bf16_t* T, F f) {
  const int tid = threadIdx.x, lane = tid & 63, wave = tid >> 6;
  const int wm = wave >> 1, wn = wave & 1;
#pragma unroll
  for (int i = 0; i < 2; i++)
#pragma unroll
    for (int j = 0; j < 2; j++)
#pragma unroll
      for (int q = 0; q < 4; q++) {
        const int rowl = wm * 64 + i * 32 + (lane & 31);
        const int coll = wn * 64 + j * 32 + (lane >> 5) * 4 + 8 * q;
        const int cg = ctile0 + coll;
        *(uint2*)(T + rowl * 136 + coll) = make_uint2(cvtpk(f(cg, acc[i][j][4 * q]), f(cg + 1, acc[i][j][4 * q + 1])),
                                                      cvtpk(f(cg + 2, acc[i][j][4 * q + 2]), f(cg + 3, acc[i][j][4 * q + 3])));
      }
  __syncthreads();
#pragma unroll
  for (int k = 0; k < 8; k++) {
    const int c = tid + 256 * k;
    const int row = c >> 4, ch = c & 15;
    *(uint4*)(out + (size_t)(m0 + row) * ld + c0 + ch * 8) = *(const uint4*)(T + row * 136 + ch * 8);
  }
}

__device__ __forceinline__ bool xcd_tile(int k, int MT, int NT, int& tm, int& col) {
  const int nb = gridDim.x, bid = blockIdx.x;
  const int total = MT * NT;
  if ((nb & 7) != 0 || (MT & 7) == 0) {
    const int idx = bid + k * nb;
    if (idx >= total) return false;
    tm = idx / NT; col = idx - tm * NT;
    return true;
  }
  const int x = bid & 7, li = bid >> 3, nloc = nb >> 3;
  const int s0 = (int)(((long long)total * x) >> 3), s1 = (int)(((long long)total * (x + 1)) >> 3);
  const int idx = s0 + li + k * nloc;
  if (idx >= s1) return false;
  const int G = MT >> 3, R = MT & 7;
  const int full = G * 8 * NT;
  if (idx < full) { const int tg = idx / (8 * NT); const int rem = idx - tg * 8 * NT; col = rem >> 3; tm = tg * 8 + (rem & 7); }
  else { const int i2 = idx - full; col = i2 / R; tm = G * 8 + (i2 - col * R); }
  return true;
}

__device__ __forceinline__ void phase_rwkv_proj(const Params& p, char* smem) {
  bf16_t* sA = (bf16_t*)smem; bf16_t* sB = sA + 128 * SAS;
  char* ws = p.ws;
  int tile = blockIdx.x;
  for (; tile < 133 * 4; tile += gridDim.x) {
    const int tm = tile >> 2, jt = tile & 3;
    const int job = (jt == 0) ? 3 : (jt == 1) ? 4 : 5;
    const int tn = (jt == 3) ? 1 : 0;
    const int mixidx = (job == 3) ? 1 : (job == 4) ? 4 : 5;
    GemmA ga;
    ga.A = (const bf16_t*)(ws + OFF_XN); ga.lda = DM;
    ga.mix = p.in[10] + mixidx * DM;
    ga.sh0 = (const bf16_t*)(ws + WT_SH0); ga.zero = (const bf16_t*)(ws + WT_ZERO);
    const bf16_t* Bt; int Nv;
    if (job == 3) { Bt = (const bf16_t*)(ws + WT_W1); Nv = 64; }
    else if (job == 4) { Bt = (const bf16_t*)(ws + WT_A1); Nv = 64; }
    else { Bt = (const bf16_t*)(ws + WT_G1); Nv = 192; }
    f32x16 acc[2][2];
    gemm_mainloop<1>(acc, ga, Bt, 1024, Nv, 1024, tm * 128, tn * 128, sA, sB);
    if (job == 3) {
      bf16_t* o = (bf16_t*)(ws + OFF_L1W);
      gemm_epilogue(acc, tm * 128, 0, [&](int row, int col, float v) { if (col < 64) o[(size_t)row * 64 + col] = f2bf(tanhf(v)); });
    } else if (job == 4) {
      bf16_t* o = (bf16_t*)(ws + OFF_L1A);
      gemm_epilogue(acc, tm * 128, 0, [&](int row, int col, float v) { if (col < 64) o[(size_t)row * 64 + col] = f2bf(v); });
    } else {
      bf16_t* o = (bf16_t*)(ws + OFF_L1G);
      gemm_epilogue(acc, tm * 128, tn * 128, [&](int row, int col, float v) { if (col < 192) o[(size_t)row * 192 + col] = f2bf(sigmoidf_(v)); });
    }
  }
  for (; tile < 133 * 28; tile += gridDim.x) {
    const int t2 = tile - 133 * 4;
    const int tm = t2 / 24, jt = t2 - tm * 24;
    const int job = jt >> 3, tn = jt & 7;
    const int mixidx = (job == 0) ? 0 : (job == 1) ? 2 : 3;
    GemmA ga;
    ga.A = (const bf16_t*)(ws + OFF_XN); ga.lda = DM;
    ga.mix = p.in[10] + mixidx * DM;
    ga.sh0 = (const bf16_t*)(ws + WT_SH0); ga.zero = (const bf16_t*)(ws + WT_ZERO);
    const bf16_t* Bt = (const bf16_t*)(ws + WT_RKV) + (size_t)job * 1048576;
    f32x16 acc[2][2];
    gemm_mainloop<1, 1>(acc, ga, Bt, 1024, 1024, 1024, tm * 128, tn * 128, sA, sB);
    bf16_t* o = (bf16_t*)(ws + (job == 0 ? OFF_R : job == 1 ? OFF_K : OFF_V));
    gemm_epilogue_bf16_lds(acc, o, DM, tm * 128, tn * 128, tn * 128, sA, [&](int, float v) { return v; });
  }
}

__device__ __forceinline__ void phase_rwkv_lora2(const Params& p, char* smem) {
  bf16_t* sA = (bf16_t*)smem; bf16_t* sB = sA + 128 * SAS;
  char* ws = p.ws;
  for (int tile = blockIdx.x; tile < 133 * 24; tile += gridDim.x) {
    const int tm = tile / 24, jt = tile - tm * 24;
    const int job = jt >> 3, tn = jt & 7;
    GemmA ga; ga.mix = nullptr; ga.sh0 = nullptr; ga.zero = nullptr;
    const bf16_t* Bt; int K;
    if (job == 0) { ga.A = (const bf16_t*)(ws + OFF_L1W); ga.lda = 64; Bt = (const bf16_t*)(ws + WT_W2); K = 64; }
    else if (job == 1) { ga.A = (const bf16_t*)(ws + OFF_L1A); ga.lda = 64; Bt = (const bf16_t*)(ws + WT_A2); K = 64; }
    else { ga.A = (const bf16_t*)(ws + OFF_L1G); ga.lda = 192; Bt = (const bf16_t*)(ws + WT_G2); K = 192; }
    f32x16 acc[2][2];
    if (job == 1) {
      gemm_mainloop<0, 1>(acc, ga, Bt, K, 1024, K, tm * 128, tn * 128, sA, sB);
      const float* a0 = p.in[15];
      gemm_epilogue_bf16_lds(acc, (bf16_t*)(ws + OFF_A), DM, tm * 128, tn * 128, tn * 128, sA, [&](int col, float v) { return sigmoidf_(a0[col] + v); });
      continue;
    }
    if (job == 2) {
      gemm_mainloop<0, 1>(acc, ga, Bt, K, 1024, K, tm * 128, tn * 128, sA, sB);
      gemm_epilogue_bf16_lds(acc, (bf16_t*)(ws + OFF_G), DM, tm * 128, tn * 128, tn * 128, sA, [&](int, float v) { return v; });
      continue;
    }
    gemm_mainloop<0>(acc, ga, Bt, K, 1024, K, tm * 128, tn * 128, sA, sB);
    if (job == 0) {
      float* o = (float*)(ws + OFF_DEC); const float* w0 = p.in[12];
      gemm_epilogue(acc, tm * 128, tn * 128, [&](int row, int col, float v) {
        const float wl = -softplusf_(-(w0[col] + v)) - 0.5f;
        o[(size_t)row * DM + col] = -__expf(wl);
      });
    } else if (job == 1) {
      bf16_t* o = (bf16_t*)(ws + OFF_A); const float* a0 = p.in[15];
      gemm_epilogue(acc, tm * 128, tn * 128, [&](int row, int col, float v) { o[(size_t)row * DM + col] = f2bf(sigmoidf_(a0[col] + v)); });
    } else {
      bf16_t* o = (bf16_t*)(ws + OFF_G);
      gemm_epilogue(acc, tm * 128, tn * 128, [&](int row, int col, float v) { o[(size_t)row * DM + col] = f2bf(v); });
    }
  }
}

typedef float f32x4v __attribute__((ext_vector_type(4)));
struct RBlk { bf16_t* base; int stride; };
__device__ __forceinline__ RBlk rwkv_blk(char* ws, size_t arr_off, int which, bool prompt, size_t tok0, int h, int sidx) {
  RBlk r;
  if (prompt) {
    if (which == 4) { r.base = (bf16_t*)(ws + OFF_DEC) + tok0 * 2048 + h * 128; r.stride = 2048; }
    else { r.base = (bf16_t*)(ws + arr_off) + tok0 * DM + h * 64; r.stride = DM; }
  }
  else { r.base = (bf16_t*)(ws + OFF_RSP) + ((size_t)sidx * 5 + which) * 1024; r.stride = 64; }
  return r;
}
__device__ __forceinline__ void phase_rwkv_prep(const Params& p, char* smem) {
  const int lane = threadIdx.x & 63, wave = threadIdx.x >> 6;
  char* ws = p.ws;
  char* wsm = smem + wave * 17856;
  bf16_t* sQR = (bf16_t*)wsm;
  bf16_t* sBK = sQR + 32 * 72;
  float* sC = (float*)(sBK + 32 * 72);
  bf16_t* sV = (bf16_t*)(sC + 32 * 33);
  float* sX = (float*)(sV + 16 * 72);
  const bf16_t* Rb = (const bf16_t*)(ws + OFF_R); const bf16_t* Kb = (const bf16_t*)(ws + OFF_K);
  const bf16_t* Vb = (const bf16_t*)(ws + OFF_V); const bf16_t* Ab = (const bf16_t*)(ws + OFF_A);
  const float* LWb = (const float*)(ws + OFF_DEC);
  float* BON = (float*)(ws + OFF_BON);
  const int c16 = lane & 15, g = lane >> 4;
  for (int it = blockIdx.x * 4 + wave; it < 18560; it += gridDim.x * 4) {
    const bool prompt = it < 16512;
    int h, nvalid, sidx = 0; size_t tok0;
    if (prompt) { h = it & 15; const int q = it >> 4; const int b = q / 129, ch = q - b * 129; tok0 = (size_t)b * LP + ch * 16; nvalid = 16; }
    else { sidx = it - 16512; h = sidx & 15; tok0 = TP + (size_t)(sidx >> 4) * 4; nvalid = 4; }
    const int col = h * 64 + lane;
    const float kkc = p.in[20][col], kac = p.in[21][col], rkc = p.in[22][col];
    float rr[16], kr[16], vr[16], ar[16], lw[16];
#pragma unroll
    for (int tt = 0; tt < 16; tt++) {
      if (tt < nvalid) {
        const size_t off = (tok0 + tt) * DM + col;
        rr[tt] = bf2f(Rb[off]); kr[tt] = bf2f(Kb[off]); vr[tt] = bf2f(Vb[off]); ar[tt] = bf2f(Ab[off]); lw[tt] = LWb[off];
      } else { rr[tt] = 0.f; kr[tt] = 0.f; vr[tt] = 0.f; ar[tt] = 0.f; lw[tt] = 0.f; }
    }
    float bi[16], ki[16];
    float cum = 0.f;
#pragma unroll
    for (int tt = 0; tt < 16; tt++) {
      float kk = kr[tt] * kkc;
      const float n2 = wave_sum(kk * kk);
      kk = kk / fmaxf(sqrtf(n2), 1e-12f);
      const float kp = kr[tt] * (1.f + (ar[tt] - 1.f) * kac);
      const float bb = kk * ar[tt];
      const float bon = wave_sum(rr[tt] * kp * rkc);
      if (tt < nvalid && lane == 0) BON[(tok0 + tt) * 16 + h] = bon;
      const float eprev = __expf(cum);
      cum += lw[tt];
      const float ecur = __expf(cum), einv = __expf(-cum);
      bi[tt] = bb * einv; ki[tt] = kp * einv;
      sQR[tt * 72 + lane] = f2bf(kk * eprev);
      sQR[(16 + tt) * 72 + lane] = f2bf(rr[tt] * ecur);
      sBK[tt * 72 + lane] = f2bf(bi[tt]);
      sBK[(16 + tt) * 72 + lane] = f2bf(ki[tt]);
      sV[tt * 72 + lane] = f2bf(vr[tt]);
    }
    const float eQ = __expf(cum);
    char* small = ws + OFF_RSM + (size_t)it * RSM_ITEM;
    ((float*)(small + 2048))[lane] = eQ;
    asm volatile("s_waitcnt lgkmcnt(0)" ::: "memory");
    __builtin_amdgcn_wave_barrier();
    {
      f32x16 acc;
#pragma unroll
      for (int r = 0; r < 16; r++) acc[r] = 0.f;
#pragma unroll
      for (int ks = 0; ks < 4; ks++) {
        const bf16x8 af = *(const bf16x8*)(sQR + (lane & 31) * 72 + ks * 16 + (lane >> 5) * 8);
        const bf16x8 bf = *(const bf16x8*)(sBK + (lane & 31) * 72 + ks * 16 + (lane >> 5) * 8);
        acc = __builtin_amdgcn_mfma_f32_32x32x16_bf16(af, bf, acc, 0, 0, 0);
      }
#pragma unroll
      for (int r = 0; r < 16; r++) sC[((lane >> 5) * 4 + (r & 3) + 8 * (r >> 2)) * 33 + (lane & 31)] = acc[r];
    }
    asm volatile("s_waitcnt lgkmcnt(0)" ::: "memory");
    __builtin_amdgcn_wave_barrier();
#pragma unroll
    for (int tt = 0; tt < 16; tt++) {
      sBK[tt * 72 + lane] = f2bf(bi[tt] * eQ);
      sBK[(16 + tt) * 72 + lane] = f2bf(ki[tt] * eQ);
    }
    {
      const int c = lane & 31;
      float xr[16];
#pragma unroll
      for (int t = 0; t < 16; t++) {
        float acc;
        if (c < 16) acc = (c == t) ? 1.f : 0.f;
        else acc = ((c - 16) < t) ? sC[t * 33 + c] : 0.f;
#pragma unroll
        for (int i = 0; i < 16; i++) if (i < t) acc -= sC[t * 33 + i] * xr[i];
        xr[t] = acc;
      }
      if (lane < 32) {
#pragma unroll
        for (int t = 0; t < 16; t++) sX[t * 33 + c] = -xr[t];
      }
    }
    asm volatile("s_waitcnt lgkmcnt(0)" ::: "memory");
    __builtin_amdgcn_wave_barrier();
    {
      float f[8];
#pragma unroll
      for (int jj = 0; jj < 4; jj++) { f[jj] = sX[c16 * 33 + 4 * g + jj]; f[4 + jj] = sX[c16 * 33 + 16 + 4 * g + jj]; }
      ((uint4*)small)[lane] = pack8(f);
#pragma unroll
      for (int jj = 0; jj < 4; jj++) {
        const int i = 4 * g + jj;
        f[jj] = (i <= c16) ? sC[(16 + c16) * 33 + i] : 0.f;
        f[4 + jj] = (i <= c16) ? sC[(16 + c16) * 33 + 16 + i] : 0.f;
      }
      ((uint4*)(small + 1024))[lane] = pack8(f);
    }
    {
      const RBlk bq = rwkv_blk(ws, OFF_R, 0, prompt, tok0, h, sidx), br = rwkv_blk(ws, OFF_K, 1, prompt, tok0, h, sidx);
#pragma unroll
      for (int m = 0; m < 2; m++) {
        const int idx = m * 64 + lane;
        const int k0 = 32 * m + 4 * g;
        const uint2 q0 = *(const uint2*)(sQR + c16 * 72 + k0), q1 = *(const uint2*)(sQR + c16 * 72 + k0 + 16);
        *(uint4*)(bq.base + (size_t)(idx >> 3) * bq.stride + (idx & 7) * 8) = make_uint4(q0.x, q0.y, q1.x, q1.y);
        const uint2 r0 = *(const uint2*)(sQR + (16 + c16) * 72 + k0), r1 = *(const uint2*)(sQR + (16 + c16) * 72 + k0 + 16);
        *(uint4*)(br.base + (size_t)(idx >> 3) * br.stride + (idx & 7) * 8) = make_uint4(r0.x, r0.y, r1.x, r1.y);
      }
    }
    {
      const RBlk b0 = rwkv_blk(ws, OFF_A, 2, prompt, tok0, h, sidx), b1 = rwkv_blk(ws, OFF_BB, 3, prompt, tok0, h, sidx);
#pragma unroll
      for (int kb = 0; kb < 4; kb++) {
        const int k = 16 * kb + c16;
        unsigned w[4];
#pragma unroll
        for (int e = 0; e < 2; e++) {
          w[e] = (unsigned)sBK[(4 * g + 2 * e) * 72 + k] | ((unsigned)sBK[(4 * g + 2 * e + 1) * 72 + k] << 16);
          w[2 + e] = (unsigned)sBK[(16 + 4 * g + 2 * e) * 72 + k] | ((unsigned)sBK[(16 + 4 * g + 2 * e + 1) * 72 + k] << 16);
        }
        const RBlk& bk = (kb < 2) ? b0 : b1;
        const int idx = (kb & 1) * 64 + lane;
        *(uint4*)(bk.base + (size_t)(idx >> 3) * bk.stride + (idx & 7) * 8) = make_uint4(w[0], w[1], w[2], w[3]);
      }
    }
    {
      const RBlk bv = rwkv_blk(ws, OFF_V, 4, prompt, tok0, h, sidx);
#pragma unroll
      for (int vq = 0; vq < 4; vq++) {
        const int v = vq * 16 + c16;
        const unsigned w0 = (unsigned)sV[(4 * g) * 72 + v] | ((unsigned)sV[(4 * g + 1) * 72 + v] << 16);
        const unsigned w1 = (unsigned)sV[(4 * g + 2) * 72 + v] | ((unsigned)sV[(4 * g + 3) * 72 + v] << 16);
        const int idx = vq * 64 + lane;
        *(uint2*)(bv.base + (size_t)(idx >> 4) * bv.stride + (idx & 15) * 4) = make_uint2(w0, w1);
      }
    }
    asm volatile("s_waitcnt lgkmcnt(0)" ::: "memory");
    __builtin_amdgcn_wave_barrier();
  }
}

struct RPf { uint4 a, b, c, d; };
__device__ __forceinline__ bf16x8 pk8(float a0, float a1, float a2, float a3, unsigned w2, unsigned w3) {
  return __builtin_bit_cast(bf16x8, make_uint4(cvtpk(a0, a1), cvtpk(a2, a3), w2, w3));
}
__device__ __forceinline__ void rwkv_scan_block(const Params& p, int hitem, char* smem) {
  const int tid = threadIdx.x, lane = tid & 63, vq = tid >> 6;
  const int c16 = lane & 15, g = lane >> 4;
  char* ws = p.ws;
  const bool prompt = hitem < 128;
  int h, nch, nvalid, sidx = 0, b; size_t tokb; const float* S0; float* Sout;
  if (prompt) { b = hitem >> 4; h = hitem & 15; nch = 129; nvalid = 16; tokb = (size_t)b * LP; S0 = nullptr; Sout = p.out + OUT3 + (size_t)hitem * 4096; }
  else { sidx = hitem - 128; b = sidx >> 4; h = sidx & 15; nch = 1; nvalid = 4; tokb = TP + (size_t)b * 4; S0 = p.in[3] + (size_t)sidx * 4096; Sout = p.out + OUT7 + (size_t)sidx * 4096; }
  f32x4v st[4];
#pragma unroll
  for (int kb = 0; kb < 4; kb++) {
    if (S0) { const float4 v = *(const float4*)(S0 + (vq * 16 + c16) * 64 + 16 * kb + 4 * g); st[kb] = f32x4v{v.x, v.y, v.z, v.w}; }
    else st[kb] = f32x4v{0.f, 0.f, 0.f, 0.f};
  }
  bf16_t* Ob = (bf16_t*)(ws + OFF_Y);
  const char *pa, *pb, *pc, *pd; size_t sta, stc, stv;
  {
    const size_t tok0 = tokb;
    const int it0 = prompt ? ((b * 129) * 16 + h) : (16512 + sidx);
    const int idx = tid & 127;
    const RBlk Ba = (tid < 128) ? rwkv_blk(ws, OFF_R, 0, prompt, tok0, h, sidx) : rwkv_blk(ws, OFF_K, 1, prompt, tok0, h, sidx);
    pa = (const char*)(Ba.base + (size_t)(idx >> 3) * Ba.stride + (idx & 7) * 8);
    const RBlk Bb = (tid < 128) ? rwkv_blk(ws, OFF_A, 2, prompt, tok0, h, sidx) : rwkv_blk(ws, OFF_BB, 3, prompt, tok0, h, sidx);
    pb = (const char*)(Bb.base + (size_t)(idx >> 3) * Bb.stride + (idx & 7) * 8);
    const char* small = ws + OFF_RSM + (size_t)it0 * RSM_ITEM;
    if (tid < 128) pc = small + tid * 16;
    else {
      const RBlk Bv = rwkv_blk(ws, OFF_V, 4, prompt, tok0, h, sidx);
      const int i2 = 2 * (tid - 128);
      pc = (const char*)(Bv.base + (size_t)(i2 >> 4) * Bv.stride + (i2 & 15) * 4);
    }
    pd = small + 2048 + (tid & 15) * 16;
    sta = (size_t)16 * DM * 2;
    stc = (size_t)16 * RSM_ITEM;
    stv = (tid < 128) ? stc : (size_t)16 * 2048 * 2;
  }
  auto issue = [&](uint4& fa, uint4& fb, uint4& fc, uint4& fd, int ch) __attribute__((always_inline)) {
    fa = *(const uint4*)(pa + (size_t)ch * sta);
    fb = *(const uint4*)(pb + (size_t)ch * sta);
    fc = *(const uint4*)(pc + (size_t)ch * stv);
    fd = *(const uint4*)(pd + (size_t)ch * stc);
  };
  auto body = [&](uint4& fa, uint4& fb, uint4& fc, uint4& fd, int ch) __attribute__((always_inline)) {
    uint4* slot = (uint4*)(smem + (ch & 1) * 12544);
    slot[tid] = fa; slot[256 + tid] = fb; slot[512 + tid] = fc;
    if (tid < 16) slot[768 + tid] = fd;
    if (ch + 8 < nch) issue(fa, fb, fc, fd, ch + 8);
    __syncthreads();
    const uint4 kq0 = slot[lane], kq1 = slot[64 + lane], rq0 = slot[128 + lane], rq1 = slot[192 + lane];
    const uint4 se0 = slot[256 + lane], se1 = slot[320 + lane], se2 = slot[384 + lane], se3 = slot[448 + lane];
    const uint4 tu = slot[512 + lane], ao = slot[576 + lane];
    const uint2 vb = ((const uint2*)(slot + 640))[vq * 64 + lane];
    const float4* pqp = (const float4*)(slot + 768);
    const f32x4v z4 = f32x4v{0.f, 0.f, 0.f, 0.f};
    const bf16x8 bs0 = __builtin_bit_cast(bf16x8, make_uint4(cvtpk(st[0][0], st[0][1]), cvtpk(st[0][2], st[0][3]), cvtpk(st[1][0], st[1][1]), cvtpk(st[1][2], st[1][3])));
    const bf16x8 bs1 = __builtin_bit_cast(bf16x8, make_uint4(cvtpk(st[2][0], st[2][1]), cvtpk(st[2][2], st[2][3]), cvtpk(st[3][0], st[3][1]), cvtpk(st[3][2], st[3][3])));
    f32x4v w1 = __builtin_amdgcn_mfma_f32_16x16x32_bf16(__builtin_bit_cast(bf16x8, kq0), bs0, z4, 0, 0, 0);
    w1 = __builtin_amdgcn_mfma_f32_16x16x32_bf16(__builtin_bit_cast(bf16x8, kq1), bs1, w1, 0, 0, 0);
    f32x4v w3 = __builtin_amdgcn_mfma_f32_16x16x32_bf16(__builtin_bit_cast(bf16x8, rq0), bs0, z4, 0, 0, 0);
    w3 = __builtin_amdgcn_mfma_f32_16x16x32_bf16(__builtin_bit_cast(bf16x8, rq1), bs1, w3, 0, 0, 0);
    const bf16x8 bu = pk8(w1[0], w1[1], w1[2], w1[3], vb.x, vb.y);
    const f32x4v u = __builtin_amdgcn_mfma_f32_16x16x32_bf16(__builtin_bit_cast(bf16x8, tu), bu, z4, 0, 0, 0);
    const bf16x8 bo = pk8(u[0], u[1], u[2], u[3], vb.x, vb.y);
    const f32x4v o = __builtin_amdgcn_mfma_f32_16x16x32_bf16(__builtin_bit_cast(bf16x8, ao), bo, w3, 0, 0, 0);
    {
      const float4 q0 = pqp[g], q1 = pqp[4 + g], q2 = pqp[8 + g], q3 = pqp[12 + g];
      st[0] = __builtin_amdgcn_mfma_f32_16x16x32_bf16(__builtin_bit_cast(bf16x8, se0), bo, st[0] * f32x4v{q0.x, q0.y, q0.z, q0.w}, 0, 0, 0);
      st[1] = __builtin_amdgcn_mfma_f32_16x16x32_bf16(__builtin_bit_cast(bf16x8, se1), bo, st[1] * f32x4v{q1.x, q1.y, q1.z, q1.w}, 0, 0, 0);
      st[2] = __builtin_amdgcn_mfma_f32_16x16x32_bf16(__builtin_bit_cast(bf16x8, se2), bo, st[2] * f32x4v{q2.x, q2.y, q2.z, q2.w}, 0, 0, 0);
      st[3] = __builtin_amdgcn_mfma_f32_16x16x32_bf16(__builtin_bit_cast(bf16x8, se3), bo, st[3] * f32x4v{q3.x, q3.y, q3.z, q3.w}, 0, 0, 0);
    }
#pragma unroll
    for (int j = 0; j < 4; j++) {
      const int t = 4 * g + j;
      if (t < nvalid) Ob[(tokb + (size_t)ch * 16 + t) * DM + h * 64 + vq * 16 + c16] = f2bf(o[j]);
    }
  };
  uint4 a0, b0, c0, d0, a1, b1, c1, d1, a2, b2, c2, d2, a3, b3, c3, d3, a4, b4, c4, d4, a5, b5, c5, d5, a6, b6, c6, d6, a7, b7, c7, d7;
  issue(a0, b0, c0, d0, 0);
  if (1 < nch) issue(a1, b1, c1, d1, 1);
  if (2 < nch) issue(a2, b2, c2, d2, 2);
  if (3 < nch) issue(a3, b3, c3, d3, 3);
  if (4 < nch) issue(a4, b4, c4, d4, 4);
  if (5 < nch) issue(a5, b5, c5, d5, 5);
  if (6 < nch) issue(a6, b6, c6, d6, 6);
  if (7 < nch) issue(a7, b7, c7, d7, 7);
  for (int cc = 0; cc < nch; cc += 8) {
    body(a0, b0, c0, d0, cc);
    if (cc + 1 < nch) body(a1, b1, c1, d1, cc + 1);
    if (cc + 2 < nch) body(a2, b2, c2, d2, cc + 2);
    if (cc + 3 < nch) body(a3, b3, c3, d3, cc + 3);
    if (cc + 4 < nch) body(a4, b4, c4, d4, cc + 4);
    if (cc + 5 < nch) body(a5, b5, c5, d5, cc + 5);
    if (cc + 6 < nch) body(a6, b6, c6, d6, cc + 6);
    if (cc + 7 < nch) body(a7, b7, c7, d7, cc + 7);
  }
#pragma unroll
  for (int kb = 0; kb < 4; kb++)
    *(float4*)(Sout + (vq * 16 + c16) * 64 + 16 * kb + 4 * g) = make_float4(st[kb][0], st[kb][1], st[kb][2], st[kb][3]);
  __syncthreads();
}

__device__ __forceinline__ void late_transposes(const Params& p, char* smem, int vb, int vnb) {
  float* tile = (float*)smem;
  char* ws = p.ws;
  __syncthreads();
  transpose_job(p.in[25], 1024, 1024, (bf16_t*)(ws + WT_WO), 1024, 1024, tile, 175, vb, vnb);
  transpose_job(p.in[34], 1024, 2048, (bf16_t*)(ws + WT_Q), 1024, 2048, tile, 128, vb, vnb);
  convert_linear(p.in[35], (bf16_t*)(ws + WT_SK), 65536, false, vb, vnb);
  transpose_job(p.in[26], 1024, 5152, (bf16_t*)(ws + WT_IN), 1024, 5152, tile, 0, vb, vnb);
  transpose_job(p.in[33], 2048, 1024, (bf16_t*)(ws + WT_OUT), 2048, 1024, tile, 64, vb, vnb);
  transpose_job(p.in[34] + 2097152, 1024, 2048, (bf16_t*)(ws + WT_Q) + 2097152, 1024, 2048, tile, 192, vb, vnb);
}

__device__ __forceinline__ void phase_rwkv_scan(const Params& p, char* smem) {
  const int nb = gridDim.x, bid = blockIdx.x;
  if (nb > 192) {
    if (bid < 128) rwkv_scan_block(p, bid, smem);
    else {
      for (int it = bid - 128; it < 2048; it += nb - 128) rwkv_scan_block(p, 128 + it, smem);
      convert_tables_fp8(p, bid - 128, nb - 128, 0);
      late_transposes(p, smem, bid - 128, nb - 128);
    }
  } else {
    for (int it = bid; it < 128 + 2048; it += nb) rwkv_scan_block(p, it, smem);
    convert_tables_fp8(p, bid, nb, 0);
    late_transposes(p, smem, bid, nb);
  }
}

__device__ __forceinline__ void phase_rwkv_out(const Params& p) {
  const int lane = threadIdx.x & 63, wave = threadIdx.x >> 6;
  char* ws = p.ws;
  bf16_t* Yb = (bf16_t*)(ws + OFF_Y);
  const bf16_t* Vb = (const bf16_t*)(ws + OFF_V); const bf16_t* Gb = (const bf16_t*)(ws + OFF_G);
  const float* BON = (const float*)(ws + OFF_BON);
  for (int it = blockIdx.x * 4 + wave; it < TT * 2; it += gridDim.x * 4) {
    const int col = (it & 1) * 512 + lane * 8;
    const size_t off = (size_t)(it >> 1) * DM + col;
    float o[8], v[8], g[8], y[8];
    unpack8(*(const uint4*)(Yb + off), o); unpack8(*(const uint4*)(Vb + off), v); unpack8(*(const uint4*)(Gb + off), g);
    const float bon = BON[(size_t)(it >> 1) * 16 + (it & 1) * 8 + (lane >> 3)];
    const float4 w0 = *(const float4*)(p.in[23] + col), w1 = *(const float4*)(p.in[23] + col + 4);
    const float4 b0 = *(const float4*)(p.in[24] + col), b1 = *(const float4*)(p.in[24] + col + 4);
    const float lw[8] = {w0.x, w0.y, w0.z, w0.w, w1.x, w1.y, w1.z, w1.w};
    const float lb[8] = {b0.x, b0.y, b0.z, b0.w, b1.x, b1.y, b1.z, b1.w};
    float sm = 0.f;
#pragma unroll
    for (int e = 0; e < 8; e++) sm += o[e];
    const float mu = oct_sum(sm) * (1.f / 64.f);
    float sv = 0.f;
#pragma unroll
    for (int e = 0; e < 8; e++) { o[e] -= mu; sv += o[e] * o[e]; }
    const float rs = rsqrtf(oct_sum(sv) * (1.f / 64.f) + 64e-5f);
#pragma unroll
    for (int e = 0; e < 8; e++) y[e] = (o[e] * rs * lw[e] + lb[e] + bon * v[e]) * g[e];
    *(uint4*)(Yb + off) = pack8(y);
  }
}

__device__ __forceinline__ void phase_gemm_hadd(const Params& p, char* smem, const bf16_t* A, int lda, const bf16_t* Bt, int K, bool dry = false) {
  bf16_t* sA = (bf16_t*)smem; bf16_t* sB = sA + 128 * SAS;
  float* H = (float*)(p.ws + OFF_H);
  for (int kk_ = 0;; kk_++) {
    int tm, tn;
    if (!xcd_tile(kk_, 133, 8, tm, tn)) break;
    GemmA ga; ga.A = A; ga.lda = lda; ga.mix = nullptr; ga.sh0 = nullptr; ga.zero = nullptr;
    f32x16 acc[2][2];
    gemm_mainloop<0>(acc, ga, Bt, K, 1024, K, tm * 128, tn * 128, sA, sB);
    gemm_epilogue(acc, tm * 128, tn * 128, [&](int row, int col, float v) { if (!dry || v == 1.2345e30f) H[(size_t)row * DM + col] += v; });
  }
}

__device__ __forceinline__ void phase_peer_norm(const Params& p, int layer) {
  const int tid = threadIdx.x, lane = tid & 63, wave = tid >> 6;
  const float* H = (const float*)(p.ws + OFF_H);
  bf16_t* XN2 = (bf16_t*)(p.ws + (layer ? OFF_XN2_1 : OFF_XN2_0));
  const float4* g = (const float4*)(p.in[8] + layer * DM);
  for (int t = blockIdx.x * 4 + wave; t < TT; t += gridDim.x * 4) {
    float4 v[4]; float ss = 0.f;
#pragma unroll
    for (int i = 0; i < 4; i++) {
      v[i] = ((const float4*)(H + (size_t)t * DM))[i * 64 + lane];
      ss += v[i].x * v[i].x + v[i].y * v[i].y + v[i].z * v[i].z + v[i].w * v[i].w;
    }
    ss = wave_sum(ss);
    const float rstd = rsqrtf(ss * (1.f / 1024.f) + 1e-5f);
#pragma unroll
    for (int i = 0; i < 4; i++) {
      const float4 gg = g[i * 64 + lane];
      ((uint2*)(XN2 + (size_t)t * DM))[i * 64 + lane] =
          make_uint2(cvtpk(v[i].x * rstd * gg.x, v[i].y * rstd * gg.y), cvtpk(v[i].z * rstd * gg.z, v[i].w * rstd * gg.w));
    }
  }
}

__device__ __forceinline__ void phase_peer_query(const Params& p, int layer, char* smem) {
  const int tid = threadIdx.x, lane = tid & 63, wave = tid >> 6;
  const int wm = wave >> 1, wn = wave & 1;
  bf16_t* sA = (bf16_t*)smem; bf16_t* sB = sA + 128 * SAS;
  bf16_t* Qs = (bf16_t*)smem; bf16_t* Ks = Qs + 128 * 136;
  float* Ss = (float*)smem;
  char* ws = p.ws;
  const bf16_t* XN2 = (const bf16_t*)(ws + (layer ? OFF_XN2_1 : OFF_XN2_0));
  int* KEYS = (int*)(ws + (layer ? OFF_KEYS_1 : OFF_KEYS_0));
  const bf16_t* Bt = (const bf16_t*)(ws + WT_Q) + (size_t)layer * 2097152;
  for (int kk_ = 0;; kk_++) {
    int tm, tn;
    if (!xcd_tile(kk_, 133, 16, tm, tn)) break;
    GemmA ga; ga.A = XN2; ga.lda = DM; ga.mix = nullptr; ga.sh0 = nullptr; ga.zero = nullptr;
    f32x16 acc[2][2];
    gemm_mainloop<0>(acc, ga, Bt, 1024, 2048, 1024, tm * 128, tn * 128, sA, sB);
    __syncthreads();
#pragma unroll
    for (int i = 0; i < 2; i++)
#pragma unroll
      for (int j = 0; j < 2; j++)
#pragma unroll
        for (int r = 0; r < 16; r++) {
          const int rowl = wm * 64 + i * 32 + (lane >> 5) * 4 + (r & 3) + 8 * (r >> 2);
          const int coll = wn * 64 + j * 32 + (lane & 31);
          Qs[rowl * 136 + coll] = f2bf(acc[i][j][r]);
        }
    {
      const int hh = tn >> 1, z = tn & 1;
      const bf16_t* kp = (const bf16_t*)(ws + WT_SK) + ((size_t)((layer * 2 + z) * 8 + hh)) * 16384;
#pragma unroll
      for (int c = tid; c < 2048; c += 256) {
        const int key = c >> 4, dc = c & 15;
        *(uint4*)(Ks + key * 136 + dc * 8) = *(const uint4*)(kp + key * 128 + dc * 8);
      }
    }
    __syncthreads();
#pragma unroll
    for (int i = 0; i < 2; i++)
#pragma unroll
      for (int j = 0; j < 2; j++)
#pragma unroll
        for (int r = 0; r < 16; r++) acc[i][j][r] = 0.f;
#pragma unroll
    for (int ks = 0; ks < 8; ks++) {
      bf16x8 a[2], b[2];
#pragma unroll
      for (int i = 0; i < 2; i++) {
        a[i] = *(const bf16x8*)(Qs + (wm * 64 + i * 32 + (lane & 31)) * 136 + ks * 16 + (lane >> 5) * 8);
        b[i] = *(const bf16x8*)(Ks + (wn * 64 + i * 32 + (lane & 31)) * 136 + ks * 16 + (lane >> 5) * 8);
      }
#pragma unroll
      for (int i = 0; i < 2; i++)
#pragma unroll
        for (int j = 0; j < 2; j++) acc[i][j] = __builtin_amdgcn_mfma_f32_32x32x16_bf16(a[i], b[j], acc[i][j], 0, 0, 0);
    }
    __syncthreads();
#pragma unroll
    for (int i = 0; i < 2; i++)
#pragma unroll
      for (int j = 0; j < 2; j++)
#pragma unroll
        for (int r = 0; r < 16; r++) {
          const int rowl = wm * 64 + i * 32 + (lane >> 5) * 4 + (r & 3) + 8 * (r >> 2);
          const int coll = wn * 64 + j * 32 + (lane & 31);
          Ss[rowl * 136 + coll + wn * 4] = acc[i][j][r];
        }
    __syncthreads();
    {
      const int row = tid >> 1, half = tid & 1;
      int L[16];
#pragma unroll
      for (int j = 0; j < 16; j++) L[j] = (int)0x80000000;
      const float4* sp = (const float4*)(Ss + row * 136 + half * 68);
#pragma unroll 1
      for (int blk = 0; blk < 4; blk++) {
        int bk[16];
#pragma unroll
        for (int c4 = 0; c4 < 4; c4++) {
          const float4 v = sp[blk * 4 + c4];
          const int cb = half * 64 + blk * 16 + c4 * 4;
          bk[c4 * 4 + 0] = (enc_key(v.x) & ~0x7F) | (cb + 0);
          bk[c4 * 4 + 1] = (enc_key(v.y) & ~0x7F) | (cb + 1);
          bk[c4 * 4 + 2] = (enc_key(v.z) & ~0x7F) | (cb + 2);
          bk[c4 * 4 + 3] = (enc_key(v.w) & ~0x7F) | (cb + 3);
        }
        sort16_desc(bk);
        merge16_desc(L, bk);
      }
      int m[16];
#pragma unroll
      for (int j = 0; j < 16; j++) m[j] = dpp_i<0xB1>(L[15 - j]);
#pragma unroll
      for (int j = 0; j < 16; j++) m[j] = max(m[j], L[j]);
#define BSTAGE(d_)                                                                                          \
  _Pragma("unroll") for (int j = 0; j < 16; j++) if ((j & (d_)) == 0) {                                    \
    const int hi = max(m[j], m[j + (d_)]), lo = min(m[j], m[j + (d_)]); m[j] = hi; m[j + (d_)] = lo; }
      BSTAGE(8) BSTAGE(4) BSTAGE(2) BSTAGE(1)
      int4* dst = (int4*)(KEYS + ((size_t)(tm * 128 + row) * 16 + tn) * 16);
      if (half == 0) {
        dst[0] = make_int4(m[0], m[1], m[2], m[3]);
        dst[1] = make_int4(m[4], m[5], m[6], m[7]);
      } else {
        dst[2] = make_int4(m[8], m[9], m[10], m[11]);
        dst[3] = make_int4(m[12], m[13], m[14], m[15]);
      }
    }
  }
}

__device__ __forceinline__ float gelu_exact(float x) { return 0.5f * x * (1.f + erff(x * 0.70710678118654752f)); }

__device__ __forceinline__ void phase_peer_route(const Params& p, int layer) {
  char* ws = p.ws;
  const int* KEYS = (const int*)(ws + (layer ? OFF_KEYS_1 : OFF_KEYS_0));
  int* EG = (int*)(ws + (layer ? OFF_KEYS_1 : OFF_KEYS_0) + 17432576);
  for (int it = blockIdx.x * 256 + threadIdx.x; it < TT * 8; it += gridDim.x * 256) {
    const int t = it >> 3, head = it & 7;
    const int* kz0 = KEYS + ((size_t)t * 16 + head * 2) * 16;
    const int* kz1 = kz0 + 16;
    int ka[16], kb[16];
#pragma unroll
    for (int j4 = 0; j4 < 4; j4++) {
      int4 x = ((const int4*)kz0)[j4]; ka[j4 * 4] = x.x; ka[j4 * 4 + 1] = x.y; ka[j4 * 4 + 2] = x.z; ka[j4 * 4 + 3] = x.w;
      int4 y = ((const int4*)kz1)[j4]; kb[j4 * 4] = y.x; kb[j4 * 4 + 1] = y.y; kb[j4 * 4 + 2] = y.z; kb[j4 * 4 + 3] = y.w;
    }
    float af[16], bf_[16];
#pragma unroll
    for (int j = 0; j < 16; j++) { af[j] = dec_key(ka[j] & ~0x7F); bf_[j] = dec_key(kb[j] & ~0x7F); }
    int L[16];
#pragma unroll
    for (int j = 0; j < 16; j++) L[j] = (int)0x80000000;
    {
      int bk[16];
      bk[0] = (enc_key(af[0] + bf_[0]) & ~0xFF) | (0);
      bk[1] = (enc_key(af[0] + bf_[1]) & ~0xFF) | (1);
      bk[2] = (enc_key(af[0] + bf_[2]) & ~0xFF) | (2);
      bk[3] = (enc_key(af[0] + bf_[3]) & ~0xFF) | (3);
      bk[4] = (enc_key(af[0] + bf_[4]) & ~0xFF) | (4);
      bk[5] = (enc_key(af[0] + bf_[5]) & ~0xFF) | (5);
      bk[6] = (enc_key(af[0] + bf_[6]) & ~0xFF) | (6);
      bk[7] = (enc_key(af[0] + bf_[7]) & ~0xFF) | (7);
      bk[8] = (enc_key(af[0] + bf_[8]) & ~0xFF) | (8);
      bk[9] = (enc_key(af[0] + bf_[9]) & ~0xFF) | (9);
      bk[10] = (enc_key(af[0] + bf_[10]) & ~0xFF) | (10);
      bk[11] = (enc_key(af[0] + bf_[11]) & ~0xFF) | (11);
      bk[12] = (enc_key(af[0] + bf_[12]) & ~0xFF) | (12);
      bk[13] = (enc_key(af[0] + bf_[13]) & ~0xFF) | (13);
      bk[14] = (enc_key(af[0] + bf_[14]) & ~0xFF) | (14);
      bk[15] = (enc_key(af[0] + bf_[15]) & ~0xFF) | (15);
      sort16_desc(bk); merge16_desc(L, bk);
      bk[0] = (enc_key(af[1] + bf_[0]) & ~0xFF) | (16);
      bk[1] = (enc_key(af[1] + bf_[1]) & ~0xFF) | (17);
      bk[2] = (enc_key(af[1] + bf_[2]) & ~0xFF) | (18);
      bk[3] = (enc_key(af[1] + bf_[3]) & ~0xFF) | (19);
      bk[4] = (enc_key(af[1] + bf_[4]) & ~0xFF) | (20);
      bk[5] = (enc_key(af[1] + bf_[5]) & ~0xFF) | (21);
      bk[6] = (enc_key(af[1] + bf_[6]) & ~0xFF) | (22);
      bk[7] = (enc_key(af[1] + bf_[7]) & ~0xFF) | (23);
      bk[8] = (enc_key(af[2] + bf_[0]) & ~0xFF) | (32);
      bk[9] = (enc_key(af[2] + bf_[1]) & ~0xFF) | (33);
      bk[10] = (enc_key(af[2] + bf_[2]) & ~0xFF) | (34);
      bk[11] = (enc_key(af[2] + bf_[3]) & ~0xFF) | (35);
      bk[12] = (enc_key(af[2] + bf_[4]) & ~0xFF) | (36);
      bk[13] = (enc_key(af[3] + bf_[0]) & ~0xFF) | (48);
      bk[14] = (enc_key(af[3] + bf_[1]) & ~0xFF) | (49);
      bk[15] = (enc_key(af[3] + bf_[2]) & ~0xFF) | (50);
      sort16_desc(bk); merge16_desc(L, bk);
      bk[0] = (enc_key(af[3] + bf_[3]) & ~0xFF) | (51);
      bk[1] = (enc_key(af[4] + bf_[0]) & ~0xFF) | (64);
      bk[2] = (enc_key(af[4] + bf_[1]) & ~0xFF) | (65);
      bk[3] = (enc_key(af[4] + bf_[2]) & ~0xFF) | (66);
      bk[4] = (enc_key(af[5] + bf_[0]) & ~0xFF) | (80);
      bk[5] = (enc_key(af[5] + bf_[1]) & ~0xFF) | (81);
      bk[6] = (enc_key(af[6] + bf_[0]) & ~0xFF) | (96);
      bk[7] = (enc_key(af[6] + bf_[1]) & ~0xFF) | (97);
      bk[8] = (enc_key(af[7] + bf_[0]) & ~0xFF) | (112);
      bk[9] = (enc_key(af[7] + bf_[1]) & ~0xFF) | (113);
      bk[10] = (enc_key(af[8] + bf_[0]) & ~0xFF) | (128);
      bk[11] = (enc_key(af[9] + bf_[0]) & ~0xFF) | (144);
      bk[12] = (enc_key(af[10] + bf_[0]) & ~0xFF) | (160);
      bk[13] = (enc_key(af[11] + bf_[0]) & ~0xFF) | (176);
      bk[14] = (enc_key(af[12] + bf_[0]) & ~0xFF) | (192);
      bk[15] = (enc_key(af[13] + bf_[0]) & ~0xFF) | (208);
      sort16_desc(bk); merge16_desc(L, bk);
      INS16(L, (enc_key(af[14] + bf_[0]) & ~0xFF) | (224));
      INS16(L, (enc_key(af[15] + bf_[0]) & ~0xFF) | (240));
    }
    float ev[16]; float esum = 0.f;
    const float smax = dec_key(L[0] & ~0xFF);
#pragma unroll
    for (int k = 0; k < 16; k++) { ev[k] = __expf(dec_key(L[k] & ~0xFF) - smax); esum += ev[k]; }
    const float inv = 1.f / esum;
    int* eo = EG + (size_t)t * 256 + head * 16;
    int ei[16];
#pragma unroll
    for (int k = 0; k < 16; k++) {
      const int ci = (L[k] >> 4) & 15, cj = L[k] & 15;
      ei[k] = (kz0[ci] & 127) * 128 + (kz1[cj] & 127);
    }
#pragma unroll
    for (int k4 = 0; k4 < 4; k4++) {
      ((int4*)eo)[k4] = make_int4(ei[k4 * 4], ei[k4 * 4 + 1], ei[k4 * 4 + 2], ei[k4 * 4 + 3]);
      ((float4*)(eo + 128))[k4] = make_float4(ev[k4 * 4] * inv, ev[k4 * 4 + 1] * inv, ev[k4 * 4 + 2] * inv, ev[k4 * 4 + 3] * inv);
    }
  }
}

__device__ __forceinline__ float rs16(float (&q)[16], int lane) {
  const bool b0 = lane & 1, b1 = lane & 2, b2 = lane & 4, b3 = lane & 8;
  float a[8];
#pragma unroll
  for (int i = 0; i < 8; i++) { const float keep = b0 ? q[i + 8] : q[i], send = b0 ? q[i] : q[i + 8]; a[i] = keep + dpp_f<0xB1>(send); }
  float c[4];
#pragma unroll
  for (int i = 0; i < 4; i++) { const float keep = b1 ? a[i + 4] : a[i], send = b1 ? a[i] : a[i + 4]; c[i] = keep + dpp_f<0x4E>(send); }
  float d[2];
#pragma unroll
  for (int i = 0; i < 2; i++) { const float keep = b2 ? c[i + 2] : c[i], send = b2 ? c[i] : c[i + 2]; d[i] = keep + dpp_f<0x1B>(dpp_f<0x141>(send)); }
  const float keep = b3 ? d[1] : d[0], send = b3 ? d[0] : d[1];
  float v = keep + dpp_f<0x141>(dpp_f<0x140>(send));
  v += __shfl_xor(v, 16);
  v += __shfl_xor(v, 32);
  return v;
}
__device__ __forceinline__ constexpr int bitrev4(int x) { return ((x & 1) << 3) | ((x & 2) << 1) | ((x & 4) >> 1) | ((x & 8) >> 3); }

__device__ __forceinline__ void phase_peer_expert(const Params& p, int layer, char* smem, bool dry = false) {
  const int tid = threadIdx.x, lane = tid & 63, wave = tid >> 6;
  char* ws = p.ws;
  float* H = (float*)(ws + OFF_H);
  const bf16_t* XN2 = (const bf16_t*)(ws + (layer ? OFF_XN2_1 : OFF_XN2_0));
  const int* EG = (const int*)(ws + (layer ? OFF_KEYS_1 : OFF_KEYS_0) + 17432576);
  const uint2* Ub = (const uint2*)(ws + OFF_TAB) + (size_t)(layer * 2) * 16384 * 64;
  const uint2* Vb = Ub + (size_t)16384 * 64;
  const float* SCu = (const float*)(ws + WT_SC) + (layer * 2) * 16384;
  const float* SCv = SCu + 16384;
  const float* gn = layer ? p.in[9] : (p.in[7] + DM);
  const int pslot = (lane & 48) + bitrev4(lane & 15);
  const int per_round = gridDim.x * 4;
  const int nfull = TT / per_round;
  const int tail0 = nfull * per_round;
  const int ntail = TT - tail0;
  const int my_tail = ((int)blockIdx.x < ntail) ? ((ntail - 1 - (int)blockIdx.x) / (int)gridDim.x + 1) : 0;
  float* part = (float*)smem;
  for (int it = 0; it < nfull + my_tail; it++) {
    const bool coop = it >= nfull;
    const int t = coop ? (tail0 + (int)blockIdx.x + (it - nfull) * (int)gridDim.x) : (it * per_round + (int)blockIdx.x * 4 + wave);
    const int eb0 = coop ? wave * 32 : 0, eb1 = coop ? eb0 + 32 : 128;
    const int* eg = EG + (size_t)t * 256;
    const int e_lin0 = eg[lane], e_lin1 = eg[64 + lane];
    const int e_lo = eg[pslot], e_hi = eg[64 + pslot];
    const float g_lo = __int_as_float(eg[128 + pslot]), g_hi = __int_as_float(eg[192 + pslot]);
    const float su_lo = SCu[e_lo], su_hi = SCu[e_hi], sv_lo = SCv[e_lo], sv_hi = SCv[e_hi];
    f32x2_t x2[8];
    {
      const uint4 xa = *(const uint4*)(XN2 + (size_t)t * DM + lane * 16);
      const uint4 xb = *(const uint4*)(XN2 + (size_t)t * DM + lane * 16 + 8);
      x2[0] = f32x2_t{bflo(xa.x), bfhi(xa.x)}; x2[1] = f32x2_t{bflo(xa.y), bfhi(xa.y)};
      x2[2] = f32x2_t{bflo(xa.z), bfhi(xa.z)}; x2[3] = f32x2_t{bflo(xa.w), bfhi(xa.w)};
      x2[4] = f32x2_t{bflo(xb.x), bfhi(xb.x)}; x2[5] = f32x2_t{bflo(xb.y), bfhi(xb.y)};
      x2[6] = f32x2_t{bflo(xb.z), bfhi(xb.z)}; x2[7] = f32x2_t{bflo(xb.w), bfhi(xb.w)};
    }
    float d0 = 0.f, d1 = 0.f;
    for (int eb = eb0; eb < eb1; eb += 32) {
      const int esel = (eb < 64) ? e_lin0 : e_lin1;
      uint2 ua[32];
#pragma unroll
      for (int j = 0; j < 32; j++) {
        const int row = __builtin_amdgcn_readlane(esel, (eb + j) & 63);
        ua[j] = (Ub + (size_t)row * 64)[lane];
      }
#pragma unroll
      for (int hb = 0; hb < 2; hb++) {
        float q[16];
#pragma unroll
        for (int j = 0; j < 16; j++) {
          const uint2 u = ua[hb * 16 + j];
          f32x2_t a2 = __builtin_amdgcn_cvt_scalef32_pk_f32_fp4(u.x, 1.0f, 0) * x2[0];
          a2 += __builtin_amdgcn_cvt_scalef32_pk_f32_fp4(u.x, 1.0f, 1) * x2[1];
          a2 += __builtin_amdgcn_cvt_scalef32_pk_f32_fp4(u.x, 1.0f, 2) * x2[2];
          a2 += __builtin_amdgcn_cvt_scalef32_pk_f32_fp4(u.x, 1.0f, 3) * x2[3];
          a2 += __builtin_amdgcn_cvt_scalef32_pk_f32_fp4(u.y, 1.0f, 0) * x2[4];
          a2 += __builtin_amdgcn_cvt_scalef32_pk_f32_fp4(u.y, 1.0f, 1) * x2[5];
          a2 += __builtin_amdgcn_cvt_scalef32_pk_f32_fp4(u.y, 1.0f, 2) * x2[6];
          a2 += __builtin_amdgcn_cvt_scalef32_pk_f32_fp4(u.y, 1.0f, 3) * x2[7];
          q[j] = a2.x + a2.y;
        }
        const float v = rs16(q, lane);
        const int bt = (eb >> 4) + hb;
        if ((lane >> 4) == (bt & 3)) { if (bt < 4) d0 = v; else d1 = v; }
      }
    }
    const float c0 = g_lo * gelu_exact(d0 * su_lo) * sv_lo;
    const float c1 = g_hi * gelu_exact(d1 * su_hi) * sv_hi;
    f32x2_t o2[8];
#pragma unroll
    for (int i = 0; i < 8; i++) o2[i] = f32x2_t{0.f, 0.f};
    for (int eb = eb0; eb < eb1; eb += 32) {
      const int esel = (eb < 64) ? e_lin0 : e_lin1;
      uint2 va[32];
#pragma unroll
      for (int j = 0; j < 32; j++) {
        const int row = __builtin_amdgcn_readlane(esel, (eb + j) & 63);
        va[j] = (Vb + (size_t)row * 64)[lane];
      }
      const float csel = (eb < 64) ? c0 : c1;
      const int rbase = ((eb >> 4) & 3) * 16;
#pragma unroll
      for (int j = 0; j < 32; j++) {
        const float c = rdlane(csel, rbase + (j >> 4) * 16 + bitrev4(j & 15));
        const f32x2_t cc = f32x2_t{c, c};
        o2[0] += cc * __builtin_amdgcn_cvt_scalef32_pk_f32_fp4(va[j].x, 1.0f, 0);
        o2[1] += cc * __builtin_amdgcn_cvt_scalef32_pk_f32_fp4(va[j].x, 1.0f, 1);
        o2[2] += cc * __builtin_amdgcn_cvt_scalef32_pk_f32_fp4(va[j].x, 1.0f, 2);
        o2[3] += cc * __builtin_amdgcn_cvt_scalef32_pk_f32_fp4(va[j].x, 1.0f, 3);
        o2[4] += cc * __builtin_amdgcn_cvt_scalef32_pk_f32_fp4(va[j].y, 1.0f, 0);
        o2[5] += cc * __builtin_amdgcn_cvt_scalef32_pk_f32_fp4(va[j].y, 1.0f, 1);
        o2[6] += cc * __builtin_amdgcn_cvt_scalef32_pk_f32_fp4(va[j].y, 1.0f, 2);
        o2[7] += cc * __builtin_amdgcn_cvt_scalef32_pk_f32_fp4(va[j].y, 1.0f, 3);
      }
    }
    if (coop) {
      __syncthreads();
#pragma unroll
      for (int f4 = 0; f4 < 4; f4++)
        *(float4*)(part + wave * 1024 + lane * 16 + f4 * 4) = make_float4(o2[f4 * 2].x, o2[f4 * 2].y, o2[f4 * 2 + 1].x, o2[f4 * 2 + 1].y);
      __syncthreads();
      if (wave != 0) continue;
#pragma unroll
      for (int w = 1; w < 4; w++)
#pragma unroll
        for (int f4 = 0; f4 < 4; f4++) {
          const float4 v = *(const float4*)(part + w * 1024 + lane * 16 + f4 * 4);
          o2[f4 * 2].x += v.x; o2[f4 * 2].y += v.y; o2[f4 * 2 + 1].x += v.z; o2[f4 * 2 + 1].y += v.w;
        }
    }
    float* hp = H + (size_t)t * DM + lane * 16;
    float hn[16]; float ss = 0.f;
#pragma unroll
    for (int f4 = 0; f4 < 4; f4++) {
      const float4 v = *(const float4*)(hp + f4 * 4);
      const int i = f4 * 4;
      hn[i] = v.x + o2[f4 * 2].x; hn[i + 1] = v.y + o2[f4 * 2].y; hn[i + 2] = v.z + o2[f4 * 2 + 1].x; hn[i + 3] = v.w + o2[f4 * 2 + 1].y;
      ss += hn[i] * hn[i] + hn[i + 1] * hn[i + 1] + hn[i + 2] * hn[i + 2] + hn[i + 3] * hn[i + 3];
    }
    ss = wave_sum(ss);
    const float rstd = rsqrtf(ss * (1.f / 1024.f) + 1e-5f);
    float yn[16];
#pragma unroll
    for (int f4 = 0; f4 < 4; f4++) {
      const float4 g = *(const float4*)(gn + lane * 16 + f4 * 4);
      const int i = f4 * 4;
      yn[i] = hn[i] * rstd * g.x; yn[i + 1] = hn[i + 1] * rstd * g.y; yn[i + 2] = hn[i + 2] * rstd * g.z; yn[i + 3] = hn[i + 3] * rstd * g.w;
    }
    if (dry && rstd != 123.456f) continue;
    if (layer == 0) {
      bf16_t* xnm = (bf16_t*)(ws + OFF_XNM) + (size_t)t * DM + lane * 16;
#pragma unroll
      for (int f4 = 0; f4 < 4; f4++) *(float4*)(hp + f4 * 4) = make_float4(hn[f4 * 4], hn[f4 * 4 + 1], hn[f4 * 4 + 2], hn[f4 * 4 + 3]);
      *(uint4*)(xnm) = make_uint4(cvtpk(yn[0], yn[1]), cvtpk(yn[2], yn[3]), cvtpk(yn[4], yn[5]), cvtpk(yn[6], yn[7]));
      *(uint4*)(xnm + 8) = make_uint4(cvtpk(yn[8], yn[9]), cvtpk(yn[10], yn[11]), cvtpk(yn[12], yn[13]), cvtpk(yn[14], yn[15]));
    } else {
      float* dst = nullptr;
      if (t < TP) { const int b = t / LP, l = t - b * LP; if (l >= 16) dst = p.out + OUT0 + ((size_t)b * 2048 + (l - 16)) * DM; }
      else dst = p.out + OUT1 + (size_t)(t - TP) * DM;
      if (dst) {
#pragma unroll
        for (int f4 = 0; f4 < 4; f4++) *(float4*)(dst + lane * 16 + f4 * 4) = make_float4(yn[f4 * 4], yn[f4 * 4 + 1], yn[f4 * 4 + 2], yn[f4 * 4 + 3]);
      }
    }
  }
}

__device__ __forceinline__ void phase_mamba_inproj(const Params& p, char* smem) {
  bf16_t* sA = (bf16_t*)smem; bf16_t* sB = sA + 128 * SAS;
  char* ws = p.ws;
  bf16_t* Z = (bf16_t*)(ws + OFF_Z); bf16_t* XBC = (bf16_t*)(ws + OFF_XBC); float* DTR = (float*)(ws + OFF_DTR);
  for (int kk_ = 0;; kk_++) {
    int tm, tn;
    if (!xcd_tile(kk_, 133, 41, tm, tn)) break;
    GemmA ga; ga.A = (const bf16_t*)(ws + OFF_XNM); ga.lda = DM; ga.mix = nullptr; ga.sh0 = nullptr; ga.zero = nullptr;
    f32x16 acc[2][2];
    if (tn < 40) {
      gemm_mainloop<0, 1>(acc, ga, (const bf16_t*)(ws + WT_IN), 1024, 5152, 1024, tm * 128, tn * 128, sA, sB);
      if (tn < 16) gemm_epilogue_bf16_lds(acc, Z, 2048, tm * 128, tn * 128, 0, sA, [&](int, float v) { return v; });
      else gemm_epilogue_bf16_lds(acc, XBC, 3072, tm * 128, tn * 128 - 2048, 0, sA, [&](int, float v) { return v; });
      continue;
    }
    gemm_mainloop<0>(acc, ga, (const bf16_t*)(ws + WT_IN), 1024, 5152, 1024, tm * 128, tn * 128, sA, sB);
    if (tn < 16) {
      gemm_epilogue(acc, tm * 128, tn * 128, [&](int row, int col, float v) { Z[(size_t)row * 2048 + col] = f2bf(v); });
    } else if (tn < 40) {
      gemm_epilogue(acc, tm * 128, tn * 128 - 2048, [&](int row, int col, float v) { XBC[(size_t)row * 3072 + col] = f2bf(v); });
    } else {
      gemm_epilogue(acc, tm * 128, 0, [&](int row, int col, float v) { if (col < 32) DTR[(size_t)row * 32 + col] = v; });
    }
  }
}

__device__ __forceinline__ void phase_mamba_conv(const Params& p) {
  char* ws = p.ws;
  const bf16_t* XBC = (const bf16_t*)(ws + OFF_XBC);
  bf16_t* XC = (bf16_t*)(ws + OFF_XC);
  const float* cw = p.in[27]; const float* cb = p.in[28];
  for (int it = blockIdx.x * 256 + threadIdx.x; it < TT * 384; it += gridDim.x * 256) {
    const int t = it / 384, c8 = (it - t * 384) * 8;
    int b, l; const float* c0 = nullptr;
    if (t < TP) { b = t / LP; l = t - b * LP; } else { const int s = t - TP; b = s >> 2; l = s & 3; c0 = p.in[4] + (size_t)b * 9216; }
    float acc[8];
    {
      const float4 b0 = *(const float4*)(cb + c8), b1 = *(const float4*)(cb + c8 + 4);
      acc[0] = b0.x; acc[1] = b0.y; acc[2] = b0.z; acc[3] = b0.w; acc[4] = b1.x; acc[5] = b1.y; acc[6] = b1.z; acc[7] = b1.w;
    }
#pragma unroll
    for (int j = 0; j < 4; j++) {
      const int ll = l - 3 + j;
      float x[8];
      if (ll >= 0) {
        unpack8(*(const uint4*)(XBC + (size_t)(t - 3 + j) * 3072 + c8), x);
      } else if (c0) {
        const float4 v0 = *(const float4*)(c0 + (3 + ll) * 3072 + c8), v1 = *(const float4*)(c0 + (3 + ll) * 3072 + c8 + 4);
        x[0] = v0.x; x[1] = v0.y; x[2] = v0.z; x[3] = v0.w; x[4] = v1.x; x[5] = v1.y; x[6] = v1.z; x[7] = v1.w;
      } else {
#pragma unroll
        for (int e = 0; e < 8; e++) x[e] = 0.f;
      }
      const float4 w0 = *(const float4*)(cw + j * 3072 + c8), w1 = *(const float4*)(cw + j * 3072 + c8 + 4);
      acc[0] += w0.x * x[0]; acc[1] += w0.y * x[1]; acc[2] += w0.z * x[2]; acc[3] += w0.w * x[3];
      acc[4] += w1.x * x[4]; acc[5] += w1.y * x[5]; acc[6] += w1.z * x[6]; acc[7] += w1.w * x[7];
    }
#pragma unroll
    for (int e = 0; e < 8; e++) acc[e] = acc[e] * sigmoidf_(acc[e]);
    *(uint4*)(XC + (size_t)t * 3072 + c8) = pack8(acc);
  }
}

#define MCH 16
#define MSTRIDE (MCH * 136 * 2 + MCH * 64 * 2 + 2 * MCH)
__device__ __forceinline__ int padn(int n) { return n + ((n >> 6) << 2); }
struct MVec { float4 B[4], C[4]; float2 xx; float dt, dA; };
__device__ __forceinline__ void mamba_ld(MVec& m, const float* sB, int st, int nq, int pp) {
#pragma unroll
  for (int j4 = 0; j4 < 4; j4++) {
    m.B[j4] = *(const float4*)(sB + st * 136 + padn(nq * 16 + j4 * 4));
    m.C[j4] = *(const float4*)(sB + MCH * 136 + st * 136 + padn(nq * 16 + j4 * 4));
  }
  m.xx = *(const float2*)(sB + 2 * MCH * 136 + st * 64 + 2 * pp);
  m.dt = sB[2 * MCH * 136 + 2 * MCH * 64 + st];
  m.dA = sB[2 * MCH * 136 + 2 * MCH * 64 + MCH + st];
}
__device__ __forceinline__ float2 mamba_step(f32x2_t (&hs)[2][8], const MVec& m, float Dk) {
  const float xd0 = m.xx.x * m.dt, xd1 = m.xx.y * m.dt;
  const f32x2_t dA2 = f32x2_t{m.dA, m.dA}, xd0v = f32x2_t{xd0, xd0}, xd1v = f32x2_t{xd1, xd1};
  f32x2_t y0 = f32x2_t{0.f, 0.f}, y1 = f32x2_t{0.f, 0.f};
#pragma unroll
  for (int j4 = 0; j4 < 4; j4++) {
    const f32x2_t Ba = f32x2_t{m.B[j4].x, m.B[j4].y}, Bb = f32x2_t{m.B[j4].z, m.B[j4].w};
    const f32x2_t Ca = f32x2_t{m.C[j4].x, m.C[j4].y}, Cb = f32x2_t{m.C[j4].z, m.C[j4].w};
    const int j = j4 * 2;
    hs[0][j] = hs[0][j] * dA2 + xd0v * Ba; hs[0][j + 1] = hs[0][j + 1] * dA2 + xd0v * Bb;
    hs[1][j] = hs[1][j] * dA2 + xd1v * Ba; hs[1][j + 1] = hs[1][j + 1] * dA2 + xd1v * Bb;
    y0 += Ca * hs[0][j]; y0 += Cb * hs[0][j + 1];
    y1 += Ca * hs[1][j]; y1 += Cb * hs[1][j + 1];
  }
  const float ys0 = oct_sum(y0.x + y0.y), ys1 = oct_sum(y1.x + y1.y);
  return make_float2(ys0 + Dk * m.xx.x, ys1 + Dk * m.xx.y);
}
__device__ __forceinline__ void mamba_scan_item(const Params& p, int item, float* sm) {
  const int tid = threadIdx.x;
  char* ws = p.ws;
  int b, hd, L, t0; const float* h0; float* hout;
  if (item < 256) { b = item >> 5; hd = item & 31; L = LP; t0 = b * LP; h0 = nullptr; hout = p.out + OUT5 + (size_t)item * 8192; }
  else { int s = item - 256; b = s >> 5; hd = s & 31; L = 4; t0 = TP + b * 4; h0 = p.in[5] + (size_t)s * 8192; hout = p.out + OUT9 + (size_t)s * 8192; }
  const int g = hd >> 3;
  const int pp = tid >> 3, nq = tid & 7;
  f32x2_t hs[2][8];
#pragma unroll
  for (int i = 0; i < 2; i++)
#pragma unroll
    for (int j4 = 0; j4 < 4; j4++) {
      float4 v = make_float4(0.f, 0.f, 0.f, 0.f);
      if (h0) v = *(const float4*)(h0 + (2 * pp + i) * 128 + nq * 16 + j4 * 4);
      hs[i][j4 * 2] = f32x2_t{v.x, v.y}; hs[i][j4 * 2 + 1] = f32x2_t{v.z, v.w};
    }
  const float dtb = p.in[29][hd], Aneg = -__expf(p.in[30][hd]), Dk = p.in[31][hd];
  const bf16_t* XC = (const bf16_t*)(ws + OFF_XC);
  const float* DTR = (const float*)(ws + OFF_DTR);
  bf16_t* Y2 = (bf16_t*)(ws + OFF_Y2);
  const int fst = tid >> 4, fq = tid & 15;
  struct PF { uint4 fB, fC; uint2 fX; float dtr; };
  PF pfA, pfB;
  auto prefetch = [&](PF& f, int c0) {
    if (c0 + fst < L) {
      const size_t tok = (size_t)(t0 + c0 + fst);
      f.fB = *(const uint4*)(XC + tok * 3072 + 2048 + g * 128 + fq * 8);
      f.fC = *(const uint4*)(XC + tok * 3072 + 2560 + g * 128 + fq * 8);
      f.fX = *(const uint2*)(XC + tok * 3072 + hd * 64 + fq * 4);
      if (fq == 0) f.dtr = DTR[tok * 32 + hd];
    }
  };
  auto chunk = [&](PF& f, int c0, int par) {
    float* sB = sm + par * MSTRIDE;
    float* sYv = sB + 2 * MCH * 136 + MCH * 64;
    if (c0 + fst < L) {
      float v[8];
      unpack8(f.fB, v);
      *(float4*)(sB + fst * 136 + padn(fq * 8)) = make_float4(v[0], v[1], v[2], v[3]);
      *(float4*)(sB + fst * 136 + padn(fq * 8 + 4)) = make_float4(v[4], v[5], v[6], v[7]);
      unpack8(f.fC, v);
      *(float4*)(sB + MCH * 136 + fst * 136 + padn(fq * 8)) = make_float4(v[0], v[1], v[2], v[3]);
      *(float4*)(sB + MCH * 136 + fst * 136 + padn(fq * 8 + 4)) = make_float4(v[4], v[5], v[6], v[7]);
      *(float4*)(sB + 2 * MCH * 136 + fst * 64 + fq * 4) = make_float4(bflo(f.fX.x), bfhi(f.fX.x), bflo(f.fX.y), bfhi(f.fX.y));
      if (fq == 0) {
        const float dt = softplusf_(f.dtr + dtb);
        sB[2 * MCH * 136 + 2 * MCH * 64 + fst] = dt;
        sB[2 * MCH * 136 + 2 * MCH * 64 + MCH + fst] = __expf(dt * Aneg);
      }
    }
    __syncthreads();
    if (c0 + 2 * MCH < L) prefetch(f, c0 + 2 * MCH);
    const int nst = min(MCH, L - c0);
    MVec ma, mb;
    mamba_ld(ma, sB, 0, nq, pp);
    for (int st = 0; st < nst; st += 2) {
      mamba_ld(mb, sB, st + 1, nq, pp);
      const float2 ya = mamba_step(hs, ma, Dk);
      if (nq == 0) *(float2*)(sYv + st * 64 + 2 * pp) = ya;
      if (st + 2 < nst) mamba_ld(ma, sB, st + 2, nq, pp);
      const float2 yb = mamba_step(hs, mb, Dk);
      if (nq == 0) *(float2*)(sYv + (st + 1) * 64 + 2 * pp) = yb;
    }
    __syncthreads();
    if (c0 + fst < L) {
      const float4 v = *(const float4*)(sYv + fst * 64 + fq * 4);
      *(uint2*)(Y2 + (size_t)(t0 + c0 + fst) * 2048 + hd * 64 + fq * 4) = make_uint2(cvtpk(v.x, v.y), cvtpk(v.z, v.w));
    }
  };
  prefetch(pfA, 0);
  if (MCH < L) prefetch(pfB, MCH);
  for (int c0 = 0; c0 < L; c0 += 2 * MCH) {
    chunk(pfA, c0, 0);
    if (c0 + MCH < L) chunk(pfB, c0 + MCH, 1);
  }
#pragma unroll
  for (int i = 0; i < 2; i++)
#pragma unroll
    for (int j4 = 0; j4 < 4; j4++)
      *(float4*)(hout + (2 * pp + i) * 128 + nq * 16 + j4 * 4) =
          make_float4(hs[i][j4 * 2].x, hs[i][j4 * 2].y, hs[i][j4 * 2 + 1].x, hs[i][j4 * 2 + 1].y);
  __syncthreads();
}

#define MQ 64
__device__ __forceinline__ bf16x8 pack_acc8(const f32x16& a, int o) {
  uint4 u = make_uint4(cvtpk(a[o], a[o + 1]), cvtpk(a[o + 2], a[o + 3]), cvtpk(a[o + 4], a[o + 5]), cvtpk(a[o + 6], a[o + 7]));
  return __builtin_bit_cast(bf16x8, u);
}
__device__ __forceinline__ void mamba_chunk_item(const Params& p, int item, char* smem) {
  const int tid = threadIdx.x, lane = tid & 63, wave = tid >> 6;
  const int l31 = lane & 31, g2 = lane >> 5;
  char* ws = p.ws;
  const int b = item >> 5, hd = item & 31, g = hd >> 3;
  const int t0 = b * LP;
  bf16_t* Cs = (bf16_t*)smem;
  bf16_t* Bs = Cs + 64 * 136;
  bf16_t* Ms = Bs;
  bf16_t* Bt = Bs + 64 * 136;
  bf16_t* Xt = Bt + 128 * 72;
  bf16_t* Xt2 = Xt + 64 * 72;
  float* sCs = (float*)(Xt2 + 64 * 72);
  float* sDt = sCs + 64;
  const float dtb = p.in[29][hd], Aneg = -__expf(p.in[30][hd]), Dk = p.in[31][hd];
  const bf16_t* XC = (const bf16_t*)(ws + OFF_XC);
  const float* DTR = (const float*)(ws + OFF_DTR);
  bf16_t* Y2 = (bf16_t*)(ws + OFF_Y2);
  const int wi = wave >> 1, wj = wave & 1;
  f32x16 hT[4];
#pragma unroll
  for (int nb = 0; nb < 4; nb++)
#pragma unroll
    for (int r = 0; r < 16; r++) hT[nb][r] = 0.f;
  const int fs = tid >> 2, q4 = tid & 3;
  uint4 fC[4], fB[4], fX[2]; float fdt = 0.f;
  auto prefetch = [&](int c0) {
    const bool valid = (c0 + fs) < LP;
    const bf16_t* rowp = XC + (size_t)(t0 + c0 + fs) * 3072;
#pragma unroll
    for (int i = 0; i < 4; i++) {
      const int q = q4 * 4 + i;
      fC[i] = valid ? *(const uint4*)(rowp + 2560 + g * 128 + q * 8) : make_uint4(0, 0, 0, 0);
      fB[i] = valid ? *(const uint4*)(rowp + 2048 + g * 128 + q * 8) : make_uint4(0, 0, 0, 0);
    }
#pragma unroll
    for (int i = 0; i < 2; i++) {
      const int q = q4 * 2 + i;
      fX[i] = valid ? *(const uint4*)(rowp + hd * 64 + q * 8) : make_uint4(0, 0, 0, 0);
    }
    if (wave == 0) fdt = ((c0 + lane) < LP) ? DTR[(size_t)(t0 + c0 + lane) * 32 + hd] : -1e30f;
  };
  prefetch(0);
  for (int c0 = 0; c0 < LP; c0 += MQ) {
    if (wave == 0) {
      const float dt = (c0 + lane < LP) ? softplusf_(fdt + dtb) : 0.f;
      float cs = dt * Aneg;
#pragma unroll
      for (int d = 1; d < 64; d <<= 1) { const float o = __shfl_up(cs, d); if (lane >= d) cs += o; }
      sCs[lane] = cs; sDt[lane] = dt;
    }
#pragma unroll
    for (int i = 0; i < 4; i++) {
      const int q = q4 * 4 + i;
      *(uint4*)(Cs + fs * 136 + q * 8) = fC[i];
      *(uint4*)(Bs + fs * 136 + q * 8) = fB[i];
      const unsigned w[4] = {fB[i].x, fB[i].y, fB[i].z, fB[i].w};
#pragma unroll
      for (int e = 0; e < 4; e++) {
        Bt[(q * 8 + 2 * e) * 72 + fs] = (bf16_t)(w[e] & 0xffffu);
        Bt[(q * 8 + 2 * e + 1) * 72 + fs] = (bf16_t)(w[e] >> 16);
      }
    }
    __syncthreads();
    {
      const float csQ = sCs[63];
      const float sc = sDt[fs] * __expf(csQ - sCs[fs]);
#pragma unroll
      for (int i = 0; i < 2; i++) {
        const int q = q4 * 2 + i;
        const unsigned w[4] = {fX[i].x, fX[i].y, fX[i].z, fX[i].w};
#pragma unroll
        for (int e = 0; e < 4; e++) {
          Xt[(q * 8 + 2 * e) * 72 + fs] = (bf16_t)(w[e] & 0xffffu);
          Xt[(q * 8 + 2 * e + 1) * 72 + fs] = (bf16_t)(w[e] >> 16);
          const unsigned pk = cvtpk(bflo(w[e]) * sc, bfhi(w[e]) * sc);
          Xt2[(q * 8 + 2 * e) * 72 + fs] = (bf16_t)(pk & 0xffffu);
          Xt2[(q * 8 + 2 * e + 1) * 72 + fs] = (bf16_t)(pk >> 16);
        }
      }
    }
    if (c0 + MQ < LP) prefetch(c0 + MQ);
    f32x16 gacc;
#pragma unroll
    for (int r = 0; r < 16; r++) gacc[r] = 0.f;
    const bool doG = !(wi == 0 && wj == 1);
    if (doG) {
#pragma unroll
      for (int ks = 0; ks < 8; ks++) {
        const bf16x8 a = *(const bf16x8*)(Cs + (wi * 32 + l31) * 136 + ks * 16 + g2 * 8);
        const bf16x8 bb = *(const bf16x8*)(Bs + (wj * 32 + l31) * 136 + ks * 16 + g2 * 8);
        gacc = __builtin_amdgcn_mfma_f32_32x32x16_bf16(a, bb, gacc, 0, 0, 0);
      }
    }
    f32x16 yacc;
#pragma unroll
    for (int r = 0; r < 16; r++) yacc[r] = 0.f;
#pragma unroll
    for (int nb = 0; nb < 4; nb++)
#pragma unroll
      for (int kk = 0; kk < 2; kk++) {
        const bf16_t* cp = Cs + (wi * 32 + l31) * 136 + nb * 32 + kk * 16 + 4 * g2;
        const uint2 lo = *(const uint2*)(cp), hi = *(const uint2*)(cp + 8);
        const uint4 au = make_uint4(lo.x, lo.y, hi.x, hi.y);
        yacc = __builtin_amdgcn_mfma_f32_32x32x16_bf16(__builtin_bit_cast(bf16x8, au), pack_acc8(hT[nb], kk * 8), yacc, 0, 0, 0);
      }
    __syncthreads();
    if (doG) {
      const int scol = wj * 32 + l31;
      const float cs_s = sCs[scol], dt_s = sDt[scol];
#pragma unroll
      for (int r = 0; r < 16; r++) {
        const int l = wi * 32 + g2 * 4 + (r & 3) + 8 * (r >> 2);
        float v = 0.f;
        if (scol <= l) v = gacc[r] * __expf(sCs[l] - cs_s) * dt_s;
        if (scol == l) v += Dk;
        Ms[l * 72 + scol] = f2bf(v);
      }
    } else {
#pragma unroll
      for (int r = 0; r < 16; r++) {
        const int l = g2 * 4 + (r & 3) + 8 * (r >> 2);
        Ms[l * 72 + 32 + l31] = 0;
      }
    }
#pragma unroll
    for (int r = 0; r < 16; r++) {
      const int l = wi * 32 + g2 * 4 + (r & 3) + 8 * (r >> 2);
      yacc[r] *= __expf(sCs[l]);
    }
    __syncthreads();
#pragma unroll
    for (int ks = 0; ks < 4; ks++) {
      const bf16x8 a = *(const bf16x8*)(Ms + (wi * 32 + l31) * 72 + ks * 16 + g2 * 8);
      const bf16x8 bb = *(const bf16x8*)(Xt + (wj * 32 + l31) * 72 + ks * 16 + g2 * 8);
      yacc = __builtin_amdgcn_mfma_f32_32x32x16_bf16(a, bb, yacc, 0, 0, 0);
    }
#pragma unroll
    for (int r = 0; r < 16; r++) {
      const int l = wi * 32 + g2 * 4 + (r & 3) + 8 * (r >> 2);
      if (c0 + l < LP) Y2[(size_t)(t0 + c0 + l) * 2048 + hd * 64 + wj * 32 + l31] = f2bf(yacc[r]);
    }
    {
      const float dec = __expf(sCs[63]);
#pragma unroll
      for (int nb = 0; nb < 4; nb++) {
#pragma unroll
        for (int r = 0; r < 16; r++) hT[nb][r] *= dec;
#pragma unroll
        for (int ks = 0; ks < 4; ks++) {
          const bf16x8 a = *(const bf16x8*)(Bt + (nb * 32 + l31) * 72 + ks * 16 + g2 * 8);
          const bf16x8 bb = *(const bf16x8*)(Xt2 + (wj * 32 + l31) * 72 + ks * 16 + g2 * 8);
          hT[nb] = __builtin_amdgcn_mfma_f32_32x32x16_bf16(a, bb, hT[nb], 0, 0, 0);
        }
      }
    }
    __syncthreads();
  }
  if (wi == 0) {
    float* hout = p.out + OUT5 + (size_t)item * 8192;
#pragma unroll
    for (int nb = 0; nb < 4; nb++)
#pragma unroll
      for (int r = 0; r < 16; r++) {
        const int n = nb * 32 + 8 * (r >> 2) + 4 * g2 + (r & 3);
        hout[(wj * 32 + l31) * 128 + n] = hT[nb][r];
      }
  }
}

__device__ __forceinline__ void phase_mamba_scan(const Params& p, char* smem) {
  const int nb = gridDim.x, bid = blockIdx.x;
  {
    const bf16_t* XBC = (const bf16_t*)(p.ws + OFF_XBC);
    for (int i = bid * 256 + threadIdx.x; i < (8 + 128) * 9216; i += nb * 256) {
      if (i < 8 * 9216) {
        const int b = i / 9216, r = i - b * 9216, j = r / 3072, c = r - j * 3072;
        p.out[OUT4 + i] = bf2f(XBC[(size_t)(b * LP + LP - 3 + j) * 3072 + c]);
      } else {
        const int ii = i - 8 * 9216;
        const int b = ii / 9216, r = ii - b * 9216, j = r / 3072, c = r - j * 3072;
        p.out[OUT8 + ii] = bf2f(XBC[(size_t)(TP + b * 4 + 1 + j) * 3072 + c]);
      }
    }
  }
  if (nb > 320) {
    if (bid < 256) mamba_chunk_item(p, bid, smem);
    else {
      for (int it = bid; it < 256 + 4096; it += nb - 256) mamba_scan_item(p, it, (float*)smem);
      convert_tables_fp8(p, bid - 256, nb - 256, 1);
    }
  } else {
    for (int it = bid; it < 256; it += nb) mamba_chunk_item(p, it, smem);
    for (int it = 256 + bid; it < 256 + 4096; it += nb) mamba_scan_item(p, it, (float*)smem);
    convert_tables_fp8(p, bid, nb, 1);
  }
}

__device__ __forceinline__ void phase_mamba_gate(const Params& p) {
  const int tid = threadIdx.x, lane = tid & 63, wave = tid >> 6;
  char* ws = p.ws;
  const bf16_t* Y2 = (const bf16_t*)(ws + OFF_Y2); const bf16_t* Z = (const bf16_t*)(ws + OFF_Z);
  bf16_t* YG = (bf16_t*)(ws + OFF_YG);
  const float* nw = p.in[32];
  for (int t = blockIdx.x * 4 + wave; t < TT; t += gridDim.x * 4) {
#pragma unroll
    for (int c = 0; c < 4; c++) {
      const size_t off = (size_t)t * 2048 + c * 512 + lane * 8;
      const uint4 yv = *(const uint4*)(Y2 + off), zv = *(const uint4*)(Z + off);
      float y[8], z[8];
      y[0] = bflo(yv.x); y[1] = bfhi(yv.x); y[2] = bflo(yv.y); y[3] = bfhi(yv.y); y[4] = bflo(yv.z); y[5] = bfhi(yv.z); y[6] = bflo(yv.w); y[7] = bfhi(yv.w);
      z[0] = bflo(zv.x); z[1] = bfhi(zv.x); z[2] = bflo(zv.y); z[3] = bfhi(zv.y); z[4] = bflo(zv.z); z[5] = bfhi(zv.z); z[6] = bflo(zv.w); z[7] = bfhi(zv.w);
      float ss = 0.f;
#pragma unroll
      for (int e = 0; e < 8; e++) { y[e] = y[e] * z[e] * sigmoidf_(z[e]); ss += y[e] * y[e]; }
      ss = wave_sum(ss);
      const float rstd = rsqrtf(ss * (1.f / 512.f) + 1e-5f);
      const float4 w0 = *(const float4*)(nw + c * 512 + lane * 8), w1 = *(const float4*)(nw + c * 512 + lane * 8 + 4);
      *(uint4*)(YG + off) = make_uint4(cvtpk(y[0] * rstd * w0.x, y[1] * rstd * w0.y), cvtpk(y[2] * rstd * w0.z, y[3] * rstd * w0.w),
                                       cvtpk(y[4] * rstd * w1.x, y[5] * rstd * w1.y), cvtpk(y[6] * rstd * w1.z, y[7] * rstd * w1.w));
    }
  }
}


#define XB_TMO      128
#define XB_XCNT(j)  (256  + 64 * (j))
#define XB_XSUB(j)  (1280 + 64 * (j))
#define XB_XGEN(j)  (2304 + 64 * (j))
#define XB_TOP      3328
#define XB_TOPGEN   3392
#define XCD_BAR_WORDS 3456
#define XB_SPIN_CAP (1u << 20)
#define LAS __attribute__((address_space(3)))
__device__ __forceinline__ unsigned xb_ld(unsigned* p)              { return __hip_atomic_load(p, __ATOMIC_RELAXED, __HIP_MEMORY_SCOPE_AGENT); }
__device__ __forceinline__ unsigned xb_add(unsigned* p, unsigned v) { return __hip_atomic_fetch_add(p, v, __ATOMIC_RELAXED, __HIP_MEMORY_SCOPE_AGENT); }
__device__ __forceinline__ unsigned xb_xcc_id() { return (unsigned)__builtin_amdgcn_s_getreg((3 << 11) | 20) & 0xFu; }
#define XB_SPIN(cond, bar) do { unsigned _sp = 0; while (cond) { __builtin_amdgcn_s_sleep(1); \
    if ((++_sp & 255u) == 0u) { if (xb_ld(&(bar)[XB_TMO])) break; if (_sp > XB_SPIN_CAP) { atomicAdd(&(bar)[XB_TMO], 1u); break; } } } } while (0)
struct XcdBarrier { unsigned* bar; unsigned x; volatile LAS unsigned* st; };
__device__ __forceinline__ XcdBarrier xcd_barrier_post(unsigned* bar, volatile LAS unsigned* st) {
  XcdBarrier b; b.bar = bar; b.x = xb_xcc_id(); b.st = st;
  if (threadIdx.x == 0) (void)xb_add(&bar[XB_XCNT(b.x)], 1u);
  return b;
}
__device__ __forceinline__ void xcd_barrier_complete(unsigned* bar, unsigned x, unsigned& nloc, unsigned& nx) {
  const unsigned G = gridDim.x * gridDim.y * gridDim.z;
  unsigned sum, cnt, mine, sp = 0u;
  for (;;) {
    sum = 0u; cnt = 0u; mine = 0u;
#pragma unroll
    for (unsigned j = 0; j < 16; ++j) { const unsigned c = xb_ld(&bar[XB_XCNT(j)]); sum += c; cnt += (c > 0u) ? 1u : 0u; mine = (j == x) ? c : mine; }
    if (sum == G) break;
    __builtin_amdgcn_s_sleep(1);
    if ((++sp & 255u) == 0u) { if (xb_ld(&bar[XB_TMO])) break; if (sp > XB_SPIN_CAP) { atomicAdd(&bar[XB_TMO], 1u); break; } }
  }
  nloc = mine > 0u ? mine : 1u; nx = cnt > 0u ? cnt : 1u;
}
__device__ __forceinline__ void xcd_barrier(const XcdBarrier& b) {
  asm volatile("s_waitcnt vmcnt(0)" ::: "memory");
  __syncthreads();
  if (threadIdx.x == 0) {
    unsigned* bar = b.bar;
    __builtin_amdgcn_s_waitcnt(0);
    unsigned nloc = b.st[0], nx = b.st[1];
    if (nloc == 0u) { xcd_barrier_complete(bar, b.x, nloc, nx); b.st[0] = nloc; b.st[1] = nx; }
    const unsigned old = xb_add(&bar[XB_XSUB(b.x)], 1u);
    const unsigned gen = old / nloc;
    if (old + 1u == (gen + 1u) * nloc) {
      __builtin_amdgcn_fence(__ATOMIC_RELEASE, "agent");
      asm volatile("s_waitcnt vmcnt(0)" ::: "memory");
      const unsigned og = xb_add(&bar[XB_TOP], 1u);
      const unsigned tg = og / nx;
      if (og + 1u == (tg + 1u) * nx) xb_add(&bar[XB_TOPGEN], 1u);
      else XB_SPIN(xb_ld(&bar[XB_TOPGEN]) == tg, bar);
      __builtin_amdgcn_fence(__ATOMIC_ACQUIRE, "agent");
      xb_add(&bar[XB_XGEN(b.x)], 1u);
      asm volatile("s_waitcnt vmcnt(0)" ::: "memory");
    } else {
      XB_SPIN(xb_ld(&bar[XB_XGEN(b.x)]) == gen, bar);
      __builtin_amdgcn_fence(__ATOMIC_ACQUIRE, "agent");
      asm volatile("s_waitcnt vmcnt(0)" ::: "memory");
    }
  }
  __syncthreads();
}

__global__ void __launch_bounds__(256, 2) fwd_megakernel(Params p) {
  __shared__ __attribute__((aligned(16))) char smem[73728];
  __shared__ uint4 xb_words;
  cg::grid_group grid = cg::this_grid();
  XcdBarrier xb;
  xb.bar = (unsigned*)(p.ws + OFF_BAR); xb.x = 0; xb.st = (volatile LAS unsigned*)&xb_words;
  if (p.phase_hi - p.phase_lo > 1) {
    if (threadIdx.x == 0) xb_words = make_uint4(0u, 0u, 0u, 0u);
    __syncthreads();
    xb = xcd_barrier_post((unsigned*)(p.ws + OFF_BAR), (volatile LAS unsigned*)&xb_words);
  }
#define PHASE(n_, call_)                                   \
  if (p.phase_lo <= (n_) && (n_) < p.phase_hi) {           \
    if ((n_) > p.phase_lo) {                               \
      if (p.phase_lo < 0) grid.sync(); else xcd_barrier(xb); \
    }                                                      \
    call_;                                                 \
  }
  PHASE(0, { if (PROBE & 16) phase0(p, smem); phase0(p, smem); })
  PHASE(1, { if (PROBE & 2) phase_rwkv_proj(p, smem); phase_rwkv_proj(p, smem); })
  PHASE(2, { if (PROBE & 2) phase_rwkv_lora2(p, smem); phase_rwkv_lora2(p, smem); })
  PHASE(3, phase_rwkv_prep(p, smem))
  PHASE(4, { if (PROBE & 64) phase_rwkv_scan(p, smem); phase_rwkv_scan(p, smem); })
  PHASE(5, phase_rwkv_out(p))
  PHASE(6, { if (PROBE & 2) phase_gemm_hadd(p, smem, (const bf16_t*)(p.ws + OFF_Y), DM, (const bf16_t*)(p.ws + WT_WO), 1024, true);
             phase_gemm_hadd(p, smem, (const bf16_t*)(p.ws + OFF_Y), DM, (const bf16_t*)(p.ws + WT_WO), 1024); })
  PHASE(7, { if (PROBE & 32) phase_peer_norm(p, 0); phase_peer_norm(p, 0); })
  PHASE(8, { if (PROBE & 8) phase_peer_query(p, 0, smem); phase_peer_query(p, 0, smem); })
  PHASE(9, phase_peer_route(p, 0))
  PHASE(10, { if (PROBE & 1) phase_peer_expert(p, 0, smem, true); phase_peer_expert(p, 0, smem); })
  PHASE(11, { if (PROBE & 2) phase_mamba_inproj(p, smem); phase_mamba_inproj(p, smem); })
  PHASE(12, phase_mamba_conv(p))
  PHASE(13, { if (PROBE & (4 | 128)) phase_mamba_scan(p, smem); phase_mamba_scan(p, smem); })
  PHASE(14, { if (PROBE & 32) phase_mamba_gate(p); phase_mamba_gate(p); })
  PHASE(15, { if (PROBE & 2) phase_gemm_hadd(p, smem, (const bf16_t*)(p.ws + OFF_YG), 2048, (const bf16_t*)(p.ws + WT_OUT), 2048, true);
              phase_gemm_hadd(p, smem, (const bf16_t*)(p.ws + OFF_YG), 2048, (const bf16_t*)(p.ws + WT_OUT), 2048); })
  PHASE(16, { if (PROBE & 32) phase_peer_norm(p, 1); phase_peer_norm(p, 1); })
  PHASE(17, { if (PROBE & 8) phase_peer_query(p, 1, smem); phase_peer_query(p, 1, smem); })
  PHASE(18, phase_peer_route(p, 1))
  PHASE(19, { if (PROBE & 1) phase_peer_expert(p, 1, smem, true); phase_peer_expert(p, 1, smem); })
}

extern "C" void kernel_launch(void* const* d_in, const int* in_sizes, int n_in, void* d_out, int out_size, void* d_ws,
                              size_t ws_size, hipStream_t stream) {
  static int grid_blocks = 0;
  if (!grid_blocks) {
    int dev = 0, cus = 0, per_cu = 0;
    (void)hipGetDevice(&dev);
    (void)hipDeviceGetAttribute(&cus, hipDeviceAttributeMultiprocessorCount, dev);
    (void)hipOccupancyMaxActiveBlocksPerMultiprocessor(&per_cu, fwd_megakernel, 256, 0);
    if (per_cu < 1) per_cu = 1;
    if (per_cu > 2) per_cu = 2;
    grid_blocks = cus * per_cu;
  }
  if (ws_size < WS_NEED) { fprintf(stderr, "workspace too small: %zu < %zu\n", ws_size, (size_t)WS_NEED); return; }
  Params p{};
  for (int i = 0; i < 38; i++) p.in[i] = (const float*)d_in[i];
  p.out = (float*)d_out;
  p.ws = (char*)d_ws;
#if MK_MULTI
  for (int ph = 0; ph < NPHASE; ph++) {
    p.phase_lo = ph; p.phase_hi = ph + 1;
    hipLaunchKernelGGL(fwd_megakernel, dim3(grid_blocks), dim3(256), 0, stream, p);
  }
#else
  p.phase_lo = 0; p.phase_hi = NPHASE;
  (void)hipMemsetAsync((char*)d_ws + OFF_BAR, 0, 16384, stream);
  void* args[] = {&p};
  hipError_t e = hipLaunchCooperativeKernel((void*)fwd_megakernel, dim3(grid_blocks), dim3(256), args, 0, stream);
  if (e != hipSuccess) fprintf(stderr, "cooperative launch failed: %s (grid %d)\n", hipGetErrorString(e), grid_blocks);
#endif
}
```
